# Optimizing an MI355X kernel written in HIP

```python
import math
import jax, jax.numpy as jnp
from jax import lax
import numpy as np

D_MODEL = 1024
BATCH = 2
SEQ = 8192
DEPTH = 1
DEC_BATCH = 32
DEC_SEQ = 1
PAST_LEN = 8192
PAGE_SIZE = 128

HEAD_DIM = 64
N_ATT_HEADS = 8
N_REC_HEADS = 8
REC_DK = 64
REC_DV = 64
D_ATT = N_ATT_HEADS * HEAD_DIM
D_REC_K = N_REC_HEADS * REC_DK
D_REC_V = N_REC_HEADS * REC_DV
D_MIX = D_ATT + D_REC_V
IN_SIZES = (D_ATT, D_ATT, D_ATT, D_REC_K, D_REC_K, D_REC_V, D_REC_V)
D_IN = sum(IN_SIZES)
D_FF = 4 * D_MODEL
ROPE_THETA = 500000.0
ROT_DIM = HEAD_DIM // 4
MOBA_BLOCK = 256
MOBA_TOPK = 3
Q_CHUNK = 32
REC_CHUNK = 64
EPS = 1e-6

kernel_name = "hymba_moba_hgrn2_decode_step"


def rms_norm(x, g):
    xf = x.astype(jnp.float32)
    y = xf * lax.rsqrt(jnp.mean(xf * xf, axis=-1, keepdims=True) + EPS)
    return (y * g.astype(jnp.float32)).astype(x.dtype)


def partial_rope(x, pos):
    half = ROT_DIM // 2
    inv = jnp.exp(-math.log(ROPE_THETA) * jnp.arange(half, dtype=jnp.float32) * (2.0 / ROT_DIM))
    ang = pos.astype(jnp.float32)[:, None] * inv[None, :]
    cos = jnp.cos(ang)[None, :, None, :]
    sin = jnp.sin(ang)[None, :, None, :]
    xr = x[..., :ROT_DIM].astype(jnp.float32)
    x1, x2 = xr[..., :half], xr[..., half:]
    rot = jnp.concatenate([x1 * cos - x2 * sin, x2 * cos + x1 * sin], axis=-1).astype(x.dtype)
    return jnp.concatenate([rot, x[..., ROT_DIM:]], axis=-1)


def moba_attention(q, k, v, q_pos):
    B, NQ, H, dh = q.shape
    T = k.shape[1]
    NB = T // MOBA_BLOCK
    topk = min(MOBA_TOPK, NB)
    kb = k.reshape(B, NB, MOBA_BLOCK, H, dh)
    vb = v.reshape(B, NB, MOBA_BLOCK, H, dh)
    kmean = jnp.mean(kb.astype(jnp.float32), axis=2)
    scale = HEAD_DIM ** -0.5
    c = math.gcd(NQ, Q_CHUNK)
    bi = jnp.arange(B)[:, None, None, None]
    hi = jnp.arange(H)[None, None, :, None]
    blk_ids = jnp.arange(NB, dtype=jnp.int32)
    offs = jnp.arange(MOBA_BLOCK, dtype=jnp.int32)

    def one_chunk(args):
        qc, pc = args
        own = pc // MOBA_BLOCK
        gate = jnp.einsum('bqhd,bnhd->bqhn', qc.astype(jnp.float32), kmean)
        past = blk_ids[None, :] < own[:, None]
        gate = jnp.where(past[None, :, None, :], gate, -jnp.inf)
        _, sel = lax.top_k(gate, topk)
        sel_ok = jnp.arange(topk)[None, :] < own[:, None]
        own_b = jnp.broadcast_to(own[None, :, None, None], (B, c, H, 1)).astype(sel.dtype)
        blocks = jnp.concatenate([sel, own_b], axis=-1)
        ks = kb[bi, blocks, :, hi]
        vs = vb[bi, blocks, :, hi]
        s = jnp.einsum('bqhd,bqhnkd->bqhnk', qc, ks, preferred_element_type=jnp.float32) * scale
        keypos = blocks[..., None] * MOBA_BLOCK + offs
        slot_ok = jnp.concatenate([sel_ok, jnp.ones((c, 1), dtype=bool)], axis=-1)
        mask = slot_ok[None, :, None, :, None] & (keypos <= pc[None, :, None, None, None])
        s = jnp.where(mask, s, -jnp.inf)
        p = jax.nn.softmax(s.reshape(B, c, H, -1), axis=-1).reshape(s.shape)
        return jnp.einsum('bqhnk,bqhnkd->bqhd', p.astype(v.dtype), vs)

    qs = q.reshape(B, NQ // c, c, H, dh).transpose(1, 0, 2, 3, 4)
    ps = q_pos.reshape(NQ // c, c)
    out = lax.map(one_chunk, (qs, ps))
    return out.transpose(1, 0, 2, 3, 4).reshape(B, NQ, H, dh)


def hgrn2_chunk(S, inp):
    q, kk, lf, v = inp
    C = q.shape[2]
    b = jnp.cumsum(lf, axis=2)
    o_inter = jnp.einsum('bhtk,bhkv->bhtv', q * jnp.exp(b), S)
    causal = jnp.tril(jnp.ones((C, C), dtype=bool))
    diff = b[:, :, :, None, :] - b[:, :, None, :, :]
    decay = jnp.exp(jnp.where(causal[:, :, None], diff, -jnp.inf))
    a = jnp.einsum('bhtk,bhsk,bhtsk->bhts', q, kk, decay)
    o = o_inter + jnp.einsum('bhts,bhsv->bhtv', a, v)
    b_last = b[:, :, -1:, :]
    S_new = jnp.exp(b_last[:, :, 0, :])[..., None] * S + jnp.einsum('bhsk,bhsv->bhkv', kk * jnp.exp(b_last - b), v)
    return S_new, o


def hgrn2_scan(q, kk, lf, v, S0):
    B, T, H, _ = q.shape
    c = math.gcd(T, REC_CHUNK)
    n = T // c

    def to_chunks(a):
        return a.reshape(B, n, c, H, a.shape[-1]).transpose(1, 0, 3, 2, 4)

    S, o = lax.scan(hgrn2_chunk, S0, (to_chunks(q), to_chunks(kk), to_chunks(lf), to_chunks(v)))
    o = o.transpose(1, 0, 3, 2, 4).reshape(B, T, H, v.shape[-1])
    return o, S


def mixer(a, kpast, vpast, S0, lb, w_in, hgrn_norm_g, w_out):
    B, T, _ = a.shape
    P = kpast.shape[1]
    z = a @ w_in
    qa, ka, va, qr, fr, ir, gr = jnp.split(z, list(np.cumsum(IN_SIZES)[:-1]), axis=-1)
    pos = P + jnp.arange(T, dtype=jnp.int32)
    qa = partial_rope(qa.reshape(B, T, N_ATT_HEADS, HEAD_DIM), pos)
    ka = partial_rope(ka.reshape(B, T, N_ATT_HEADS, HEAD_DIM), pos)
    va = va.reshape(B, T, N_ATT_HEADS, HEAD_DIM)
    total = P + T
    pad = (-total) % MOBA_BLOCK
    zpad = jnp.zeros((B, pad, N_ATT_HEADS, HEAD_DIM), ka.dtype)
    k_full = jnp.concatenate([kpast.astype(ka.dtype), ka, zpad], axis=1)
    v_full = jnp.concatenate([vpast.astype(va.dtype), va, zpad], axis=1)
    o_att = moba_attention(qa, k_full, v_full, pos).reshape(B, T, D_ATT)
    lbh = lb.reshape(N_REC_HEADS, REC_DK)
    f = lbh + (1.0 - lbh) * jax.nn.sigmoid(fr.astype(jnp.float32).reshape(B, T, N_REC_HEADS, REC_DK))
    o_rec, S_new = hgrn2_scan(qr.astype(jnp.float32).reshape(B, T, N_REC_HEADS, REC_DK),
                              1.0 - f, jnp.log(f),
                              ir.astype(jnp.float32).reshape(B, T, N_REC_HEADS, REC_DV),
                              S0.astype(jnp.float32))
    o_rec = rms_norm(o_rec, hgrn_norm_g) * jax.nn.silu(gr.astype(jnp.float32).reshape(B, T, N_REC_HEADS, REC_DV))
    o_rec = o_rec.astype(a.dtype).reshape(B, T, D_REC_V)
    out = jnp.concatenate([o_att, o_rec], axis=-1) @ w_out
    return out, ka, va, S_new


def layer(h, kpast, vpast, S0, lb, n1, w_in, hg, w_out, n2, w_up, w_down):
    mix, k_rows, v_rows, S_new = mixer(rms_norm(h, n1), kpast, vpast, S0, lb, w_in, hg, w_out)
    h = h + mix
    m = rms_norm(h, n2)
    h = h + jnp.square(jax.nn.relu(m @ w_up)) @ w_down
    return h, k_rows, v_rows, S_new


def setup_inputs(seed: int = 0) -> dict:
    key = jax.random.key(seed)
    ks = jax.random.split(key, 16)
    n_pages = PAST_LEN // PAGE_SIZE
    n_used = DEC_BATCH * n_pages
    n_pool = n_used + max(1, n_used // 4)
    f32 = jnp.float32
    x_prompt = jax.random.normal(ks[0], (BATCH, SEQ, D_MODEL), f32)
    x_sample = jax.random.normal(ks[1], (DEC_BATCH, DEC_SEQ, D_MODEL), f32)
    cache_k = jax.random.normal(ks[2], (DEPTH, n_pool, PAGE_SIZE, N_ATT_HEADS, HEAD_DIM), f32)
    cache_v = jax.random.normal(ks[3], (DEPTH, n_pool, PAGE_SIZE, N_ATT_HEADS, HEAD_DIM), f32)
    state_hgrn = 0.5 * jax.random.normal(ks[4], (DEPTH, DEC_BATCH, N_REC_HEADS, REC_DK, REC_DV), f32)
    page_table = jax.random.permutation(ks[5], n_pool)[:n_used].reshape(DEC_BATCH, n_pages).astype(jnp.int32)
    norm1_g = 1.0 + 0.02 * jax.random.normal(ks[6], (DEPTH, D_MODEL), f32)
    w_in = jax.random.normal(ks[7], (DEPTH, D_MODEL, D_IN), f32) * D_MODEL ** -0.5
    lb_logits = 0.1 * jax.random.normal(ks[8], (DEPTH + 1, D_REC_K), f32)
    hgrn_norm_g = 1.0 + 0.02 * jax.random.normal(ks[9], (DEPTH, REC_DV), f32)
    w_out = jax.random.normal(ks[10], (DEPTH, D_MIX, D_MODEL), f32) * D_MIX ** -0.5
    norm2_g = 1.0 + 0.02 * jax.random.normal(ks[11], (DEPTH, D_MODEL), f32)
    w_up = jax.random.normal(ks[12], (DEPTH, D_MODEL, D_FF), f32) * D_MODEL ** -0.5
    w_down = jax.random.normal(ks[13], (DEPTH, D_FF, D_MODEL), f32) * D_FF ** -0.5
    final_norm_g = 1.0 + 0.02 * jax.random.normal(ks[14], (D_MODEL,), f32)
    return {"x_prompt": x_prompt, "x_sample": x_sample, "cache_k": cache_k, "cache_v": cache_v,
            "state_hgrn": state_hgrn, "page_table": page_table, "norm1_g": norm1_g, "w_in": w_in,
            "lb_logits": lb_logits, "hgrn_norm_g": hgrn_norm_g, "w_out": w_out, "norm2_g": norm2_g,
            "w_up": w_up, "w_down": w_down, "final_norm_g": final_norm_g}


def reference(x_prompt, x_sample, cache_k, cache_v, state_hgrn, page_table, norm1_g, w_in, lb_logits,
              hgrn_norm_g, w_out, norm2_g, w_up, w_down, final_norm_g):
    lb_all = jnp.cumsum(jax.nn.softmax(lb_logits.astype(jnp.float32), axis=0), axis=0)
    n_pages = PAST_LEN // PAGE_SIZE
    Bp = x_prompt.shape[0]
    Bs = x_sample.shape[0]
    hp, hs = x_prompt, x_sample
    kp_l, vp_l, sp_l, ks_l, vs_l, ss_l = [], [], [], [], [], []
    for l in range(DEPTH):
        wargs = (lb_all[l], norm1_g[l], w_in[l], hgrn_norm_g[l], w_out[l], norm2_g[l], w_up[l], w_down[l])
        empty = jnp.zeros((Bp, 0, N_ATT_HEADS, HEAD_DIM), hp.dtype)
        S0p = jnp.zeros((Bp, N_REC_HEADS, REC_DK, REC_DV), jnp.float32)
        hp, kr, vr, Sp = layer(hp, empty, empty, S0p, *wargs)
        kp_l.append(kr); vp_l.append(vr); sp_l.append(Sp)
        kpast = cache_k[l][page_table].reshape(Bs, n_pages * PAGE_SIZE, N_ATT_HEADS, HEAD_DIM)
        vpast = cache_v[l][page_table].reshape(Bs, n_pages * PAGE_SIZE, N_ATT_HEADS, HEAD_DIM)
        hs, kr, vr, Ss = layer(hs, kpast, vpast, state_hgrn[l], *wargs)
        ks_l.append(kr); vs_l.append(vr); ss_l.append(Ss)
    y_prompt = rms_norm(hp, final_norm_g)
    y_sample = rms_norm(hs, final_norm_g)
    return (y_prompt, y_sample, jnp.stack(kp_l), jnp.stack(vp_l), jnp.stack(sp_l),
            jnp.stack(ks_l), jnp.stack(vs_l), jnp.stack(ss_l))
```

```cpp
#include <hip/hip_runtime.h>
#include <cstdio>
#include <cstdint>
namespace pg8 {
#define PG8_LAS __attribute__((address_space(3)))
typedef unsigned short bf16_t;
typedef short bf16x8 __attribute__((ext_vector_type(8)));
typedef float f32x4 __attribute__((ext_vector_type(4)));
typedef unsigned u32x4 __attribute__((ext_vector_type(4)));
constexpr int BM = 256, BK = 64, HALF = 128, HTB = HALF * BK * 2  , STAGE_BYTES = 8 * HTB, NXCD = 8, WGM = 8;

__host__ __device__ __forceinline__ int lds_byte(int r, int c) { const int st = (r >> 4) * 2 + (c >> 5), rr = r & 15, cc = c & 31, ob = rr * 64 + cc * 2; return st * 1024 + (ob ^ (((ob >> 9) & 1) << 5)); }
__host__ __device__ __forceinline__ void stage_rc(int b, int& R, int& C) { const int st = b / 1024, sb = b % 1024, swz = sb ^ (((sb >> 9) & 1) << 5); R = (st >> 1) * 16 + swz / 64; C = (st & 1) * 32 + (swz % 64) / 2; }
__host__ __device__ __forceinline__ int perm32(int rho) { const int n = rho >> 4, i = rho & 15; return 8 * (i >> 2) + 4 * n + (i & 3); }

struct Unit { int pm, pn; };
struct Gemm { const bf16_t* A; const bf16_t* Bt; int M, N, K; };

struct StaticOrder {
    int nM, nN, nwg, G, c;
    __host__ __device__ void init(int M, int N, int G_, int c_) { nM = M / BM; nN = N / BM; nwg = nM * nN; G = G_; c = c_; }
    __host__ __device__ bool next(int i, Unit& u) const {
        const long L = (long)i * G + c; if (L >= nwg) return false;
        int wgid = (int)L; { const int q = nwg / NXCD, r = nwg % NXCD, xcd = wgid % NXCD, off = wgid / NXCD; wgid = (xcd < r ? xcd * (q + 1) : r * (q + 1) + (xcd - r) * q) + off; }
        const int nig = WGM * nN, gid = wgid / nig, fm = gid * WGM, gsz = (nM - fm) < WGM ? (nM - fm) : WGM;
        u.pm = fm + ((wgid % nig) % gsz); u.pn = (wgid % nig) / gsz; return true;
    }
    __device__ __forceinline__ void a_ready(const Unit&) const {}
    __device__ __forceinline__ void done(const Unit&) const {}
};

__device__ __forceinline__ unsigned cvt_pk_bf16(float lo, float hi) { unsigned r; asm volatile("v_cvt_pk_bf16_f32 %0, %1, %2" : "=v"(r) : "v"(lo), "v"(hi)); return r; }
typedef float f32x2 __attribute__((ext_vector_type(2)));
template <class Epi, class Sched, bool ALIGN_EPI = false, bool SP2 = false>
__device__ __forceinline__ void gemm_phase(PG8_LAS unsigned char* lds, const Gemm g, const Sched& S, const Epi& E) {
    const int tid = threadIdx.x, wid = __builtin_amdgcn_readfirstlane(tid >> 6), lane = tid & 63, wr = wid >> 2, wc = wid & 3, fr = lane & 15, fq = lane >> 4;
    const int K = g.K, nt = K / BK;
    unsigned voffA[2], voffB[2];
#pragma unroll
    for (int i = 0; i < 2; ++i) { int R, C; stage_rc(tid * 16 + i * 8192, R, C); const int Rb = Epi::PERM ? ((R & ~31) + perm32(R & 31)) : R;
        voffA[i] = (unsigned)(R * K + C) * 2u; voffB[i] = (unsigned)(Rb * K + C) * 2u; }
    const size_t kstep = (size_t)(BK * 2);
    const size_t hstep = (size_t)HALF * K * 2;
    const size_t tstep = 2 * hstep;
    const unsigned ldsw = (unsigned)wid * 1024u;
    const int aoff = lds_byte(wr * 64 + fr, fq * 8), boff = lds_byte(wc * 32 + fr, fq * 8);
#define PG8_SA(b, h) (((b) * 2 + (h)) * HTB)
#define PG8_SB(b, h) ((4 + (b) * 2 + (h)) * HTB)
#define PG8_STAGE(bufoff, gbase, voff) do { _Pragma("unroll") for (int _i = 0; _i < 2; ++_i) \
        __builtin_amdgcn_global_load_lds((const unsigned*)((const char*)(gbase) + (voff)[_i]), (PG8_LAS unsigned*)(lds + (bufoff) + ldsw + _i * 8192), 16, 0, 0); } while (0)
#define PG8_LDA(dst, b, h) do { _Pragma("unroll") for (int m = 0; m < 4; ++m) _Pragma("unroll") for (int k = 0; k < 2; ++k) dst[m][k] = *(const PG8_LAS bf16x8*)(lds + PG8_SA(b, h) + aoff + m * 2048 + k * 1024); } while (0)
#define PG8_LDB(dst, b, h) do { _Pragma("unroll") for (int n = 0; n < 2; ++n) _Pragma("unroll") for (int k = 0; k < 2; ++k) dst[n][k] = *(const PG8_LAS bf16x8*)(lds + PG8_SB(b, h) + boff + n * 2048 + k * 1024); } while (0)
#define PG8_MMA(ai, bj, At, Bt) do { __builtin_amdgcn_s_setprio(1); _Pragma("unroll") for (int m = 0; m < 4; ++m) _Pragma("unroll") for (int n = 0; n < 2; ++n) _Pragma("unroll") for (int k = 0; k < 2; ++k) \
        acc[ai][bj][m][n] = __builtin_amdgcn_mfma_f32_16x16x32_bf16(Bt[n][k], At[m][k], acc[ai][bj][m][n], 0, 0, 0); __builtin_amdgcn_s_setprio(0); } while (0)
#define PG8_WAIT_V(n) asm volatile("s_waitcnt vmcnt(" #n ")" ::: "memory")
#define PG8_WAIT_L(n) asm volatile("s_waitcnt lgkmcnt(" #n ")" ::: "memory")
#define PG8_BAR __builtin_amdgcn_s_barrier()
#define PG8_SCHED __builtin_amdgcn_sched_barrier(0)
    Unit cur, nxt; int ui = 0;
    if (!S.next(0, cur)) return;
    f32x4 acc[2][2][4][2];
#pragma unroll
    for (int a = 0; a < 2; ++a)
#pragma unroll
        for (int b = 0; b < 2; ++b)
#pragma unroll
            for (int m = 0; m < 4; ++m)
#pragma unroll
                for (int n = 0; n < 2; ++n) acc[a][b][m][n] = (f32x4){0.f, 0.f, 0.f, 0.f};
    bf16x8 At[4][2], B0[2][2], B1[2][2];
    const char* cA = (const char*)g.A + (size_t)cur.pm * tstep; const char* cB = (const char*)g.Bt + (size_t)cur.pn * tstep;
    S.a_ready(cur);
    if constexpr (SP2) {
        PG8_STAGE(PG8_SB(0, 0), cB, voffB); PG8_STAGE(PG8_SB(0, 1), cB + hstep, voffB); PG8_STAGE(PG8_SA(0, 0), cA, voffA); PG8_STAGE(PG8_SA(0, 1), cA + hstep, voffA);
        if (wr == 1) PG8_BAR;
        PG8_WAIT_V(2); PG8_BAR;
        PG8_STAGE(PG8_SB(1, 0), cB + kstep, voffB); PG8_STAGE(PG8_SA(1, 0), cA + kstep, voffA); PG8_STAGE(PG8_SB(1, 1), cB + hstep + kstep, voffB);
        PG8_WAIT_V(6); PG8_BAR;
    } else {
        PG8_STAGE(PG8_SB(0, 0), cB, voffB); PG8_STAGE(PG8_SA(0, 0), cA, voffA); PG8_STAGE(PG8_SB(0, 1), cB + hstep, voffB); PG8_STAGE(PG8_SA(0, 1), cA + hstep, voffA);
        if (wr == 1) PG8_BAR;
        PG8_WAIT_V(4); PG8_BAR;
        PG8_STAGE(PG8_SB(1, 0), cB + kstep, voffB); PG8_STAGE(PG8_SA(1, 0), cA + kstep, voffA); PG8_STAGE(PG8_SB(1, 1), cB + hstep + kstep, voffB);
        PG8_WAIT_V(6); PG8_BAR;
    }
    for (;;) {
        const bool has_next = S.next(ui + 1, nxt);
        const char* nA = has_next ? (const char*)g.A + (size_t)nxt.pm * tstep : cA; const char* nB = has_next ? (const char*)g.Bt + (size_t)nxt.pn * tstep : cB;
        for (int t = 0; t < nt; t += 2) {
            const bool last = (t == nt - 2);
            const char* a1 = cA + (size_t)(t + 1) * kstep;
            const char* a2 = last ? nA : cA + (size_t)(t + 2) * kstep; const char* b2 = last ? nB : cB + (size_t)(t + 2) * kstep;
            const char* a3 = a2 + kstep; const char* b3 = b2 + kstep;
            if (last && has_next) S.a_ready(nxt);
            if constexpr (SP2) {
            PG8_LDB(B0, 0, 0); PG8_LDB(B1, 0, 1); PG8_SCHED; PG8_LDA(At, 0, 0); PG8_STAGE(PG8_SA(1, 1), a1 + hstep, voffA);
            PG8_WAIT_V(8); PG8_WAIT_L(0); PG8_BAR; PG8_MMA(0, 0, At, B0); PG8_MMA(0, 1, At, B1); PG8_BAR; PG8_SCHED;
            PG8_LDA(At, 0, 1); PG8_STAGE(PG8_SB(0, 0), b2, voffB); PG8_STAGE(PG8_SB(0, 1), b2 + hstep, voffB); PG8_STAGE(PG8_SA(0, 0), a2, voffA);
            PG8_WAIT_V(8); PG8_WAIT_L(0); PG8_BAR; PG8_MMA(1, 0, At, B0); PG8_MMA(1, 1, At, B1); PG8_BAR; PG8_SCHED;
            PG8_LDB(B0, 1, 0); PG8_LDB(B1, 1, 1); PG8_SCHED; PG8_LDA(At, 1, 0); PG8_STAGE(PG8_SA(0, 1), a2 + hstep, voffA);
            PG8_WAIT_V(8); PG8_WAIT_L(0); PG8_BAR; PG8_MMA(0, 0, At, B0); PG8_MMA(0, 1, At, B1); PG8_BAR; PG8_SCHED;
            PG8_LDA(At, 1, 1); PG8_STAGE(PG8_SB(1, 0), b3, voffB); PG8_STAGE(PG8_SB(1, 1), b3 + hstep, voffB); PG8_STAGE(PG8_SA(1, 0), a3, voffA);
            PG8_WAIT_V(8); PG8_WAIT_L(0); PG8_BAR; PG8_MMA(1, 0, At, B0); PG8_MMA(1, 1, At, B1); PG8_BAR; PG8_SCHED;
            } else {
            PG8_LDB(B0, 0, 0); PG8_SCHED; PG8_LDA(At, 0, 0); PG8_STAGE(PG8_SA(1, 1), a1 + hstep, voffA);
            PG8_WAIT_L(8); PG8_BAR; PG8_WAIT_L(0); PG8_MMA(0, 0, At, B0); PG8_BAR; PG8_SCHED;
            PG8_LDB(B1, 0, 1); PG8_STAGE(PG8_SB(0, 0), b2, voffB);
            PG8_BAR; PG8_WAIT_L(0); PG8_MMA(0, 1, At, B1); PG8_BAR;
            PG8_LDA(At, 0, 1); PG8_STAGE(PG8_SA(0, 0), a2, voffA);
            PG8_BAR; PG8_WAIT_L(0); PG8_MMA(1, 0, At, B0); PG8_BAR; PG8_SCHED;
            PG8_STAGE(PG8_SB(0, 1), b2 + hstep, voffB);
            PG8_WAIT_V(6); PG8_BAR; PG8_MMA(1, 1, At, B1); PG8_BAR;
            PG8_LDB(B0, 1, 0); PG8_SCHED; PG8_LDA(At, 1, 0); PG8_STAGE(PG8_SA(0, 1), a2 + hstep, voffA);
            PG8_WAIT_L(8); PG8_BAR; PG8_WAIT_L(0); PG8_MMA(0, 0, At, B0); PG8_BAR; PG8_SCHED;
            PG8_LDB(B1, 1, 1); PG8_STAGE(PG8_SB(1, 0), b3, voffB);
            PG8_BAR; PG8_WAIT_L(0); PG8_MMA(0, 1, At, B1); PG8_BAR;
            PG8_LDA(At, 1, 1); PG8_STAGE(PG8_SA(1, 0), a3, voffA);
            PG8_BAR; PG8_WAIT_L(0); PG8_MMA(1, 0, At, B0); PG8_BAR; PG8_SCHED;
            PG8_STAGE(PG8_SB(1, 1), b3 + hstep, voffB);
            PG8_WAIT_V(6); PG8_BAR; PG8_MMA(1, 1, At, B1); PG8_BAR;
            }
        }
        if constexpr (ALIGN_EPI) { if (wr == 0) PG8_BAR; }
        if constexpr (!Epi::AFTER_DRAIN) { E(acc, cur, wr, wc, fr, fq); S.done(cur); }
        if (!has_next) break;
#pragma unroll
        for (int a = 0; a < 2; ++a)
#pragma unroll
            for (int b = 0; b < 2; ++b)
#pragma unroll
                for (int m = 0; m < 4; ++m)
#pragma unroll
                    for (int n = 0; n < 2; ++n) acc[a][b][m][n] = (f32x4){0.f, 0.f, 0.f, 0.f};
        cur = nxt; cA = nA; cB = nB; ++ui;
        if constexpr (ALIGN_EPI) { if (wr == 1) PG8_BAR; }
    }
    PG8_WAIT_V(0);
    if constexpr (!ALIGN_EPI) { if (wr == 0) PG8_BAR; }
    PG8_BAR;
    if constexpr (Epi::AFTER_DRAIN) { E.fused(acc, cur, wr, wc, fr, fq, lds, wid, lane); S.done(cur); }
#undef PG8_SA
#undef PG8_SB
#undef PG8_STAGE
#undef PG8_LDA
#undef PG8_LDB
#undef PG8_MMA
#undef PG8_WAIT_V
#undef PG8_WAIT_L
#undef PG8_BAR
#undef PG8_SCHED
}
}
#define GAS __attribute__((address_space(1)))
#define LAS __attribute__((address_space(3)))
typedef unsigned short bf16;
typedef unsigned v4u __attribute__((ext_vector_type(4)));
typedef float f32x4 __attribute__((ext_vector_type(4)));
typedef short bf16x8 __attribute__((ext_vector_type(8)));
typedef GAS unsigned gu32;
typedef GAS unsigned long long gu64;
#define RLX_AGENT __ATOMIC_RELAXED, __HIP_MEMORY_SCOPE_AGENT
#define LDS_WAIT() asm volatile("s_waitcnt lgkmcnt(0)" ::: "memory")
#define VM_WAIT() asm volatile("s_waitcnt vmcnt(0)" ::: "memory")
__device__ __forceinline__ unsigned long long rt() { return __builtin_amdgcn_s_memrealtime(); }
__device__ __forceinline__ unsigned f2bf(float f) { unsigned u = __builtin_bit_cast(unsigned, f); return (u + 0x7fffu + ((u >> 16) & 1u)) >> 16; }
__device__ __forceinline__ unsigned pk2(float lo, float hi) { return f2bf(lo) | (f2bf(hi) << 16); }

#define XB_TMO      128
#define XB_XCNT(j)  (256  + 64 * (j))
#define XB_XSUB(j)  (1280 + 64 * (j))
#define XB_XGEN(j)  (2304 + 64 * (j))
#define XB_TOP      3328
#define XB_TOPGEN   3392
#define XCD_BAR_WORDS 3456
#define XB_SPIN_CAP (1u << 18)

__device__ __forceinline__ unsigned xb_ld(unsigned* p)              { return __hip_atomic_load(p, __ATOMIC_RELAXED, __HIP_MEMORY_SCOPE_AGENT); }
__device__ __forceinline__ unsigned xb_add(unsigned* p, unsigned v) { return __hip_atomic_fetch_add(p, v, __ATOMIC_RELAXED, __HIP_MEMORY_SCOPE_AGENT); }
__device__ __forceinline__ unsigned xb_xcc_id() { return (unsigned)__builtin_amdgcn_s_getreg((3 << 11) | 20) & 0xFu; }
#define XB_SPIN(cond, bar) do { unsigned _sp = 0; while (cond) { __builtin_amdgcn_s_sleep(1); \
    if ((++_sp & 255u) == 0u) { if (xb_ld(&(bar)[XB_TMO])) break; if (_sp > XB_SPIN_CAP) { atomicAdd(&(bar)[XB_TMO], 1u); break; } } } } while (0)

struct XcdBarrier {
    unsigned* bar; unsigned x;
    volatile LAS unsigned* st;
};

__device__ __forceinline__ XcdBarrier xcd_barrier_post(unsigned* bar, volatile LAS unsigned* st) {
    XcdBarrier b; b.bar = bar; b.x = xb_xcc_id(); b.st = st;
    if (threadIdx.x == 0) (void)xb_add(&bar[XB_XCNT(b.x)], 1u);
    return b;
}
__device__ __forceinline__ void xcd_barrier_complete(unsigned* bar, unsigned x, unsigned& nloc, unsigned& nx) {
    const unsigned G = gridDim.x * gridDim.y * gridDim.z;
    unsigned sum, cnt, mine, sp = 0u;
    for (;;) {
        sum = 0u; cnt = 0u; mine = 0u;
#pragma unroll
        for (unsigned j = 0; j < 16; ++j) { const unsigned c = xb_ld(&bar[XB_XCNT(j)]); sum += c; cnt += (c > 0u) ? 1u : 0u; mine = (j == x) ? c : mine; }
        if (sum == G) break;
        __builtin_amdgcn_s_sleep(1);
        if ((++sp & 255u) == 0u) { if (xb_ld(&bar[XB_TMO])) break; if (sp > XB_SPIN_CAP) { atomicAdd(&bar[XB_TMO], 1u); break; } }
    }
    nloc = mine > 0u ? mine : 1u; nx = cnt > 0u ? cnt : 1u;
}

__device__ __forceinline__ void xcd_barrier(const XcdBarrier& b) {
    asm volatile("s_waitcnt vmcnt(0)" ::: "memory");
    __syncthreads();
    if (threadIdx.x == 0) {
        unsigned* bar = b.bar;
        __builtin_amdgcn_s_waitcnt(0);
        unsigned nloc = b.st[0], nx = b.st[1];
        if (nloc == 0u) { xcd_barrier_complete(bar, b.x, nloc, nx); b.st[0] = nloc; b.st[1] = nx; }
        const unsigned old = xb_add(&bar[XB_XSUB(b.x)], 1u);
        const unsigned gen = old / nloc;
        if (old + 1u == (gen + 1u) * nloc) {
            __builtin_amdgcn_fence(__ATOMIC_RELEASE, "agent");
            asm volatile("s_waitcnt vmcnt(0)" ::: "memory");
            const unsigned og = xb_add(&bar[XB_TOP], 1u);
            const unsigned tg = og / nx;
            if (og + 1u == (tg + 1u) * nx) xb_add(&bar[XB_TOPGEN], 1u);
            else XB_SPIN(xb_ld(&bar[XB_TOPGEN]) == tg, bar);
            __builtin_amdgcn_fence(__ATOMIC_ACQUIRE, "agent");
            xb_add(&bar[XB_XGEN(b.x)], 1u);
            asm volatile("s_waitcnt vmcnt(0)" ::: "memory");
        } else {
            XB_SPIN(xb_ld(&bar[XB_XGEN(b.x)]) == gen, bar);
            __builtin_amdgcn_fence(__ATOMIC_ACQUIRE, "agent");
            asm volatile("s_waitcnt vmcnt(0)" ::: "memory");
        }
    }
    __syncthreads();
}

constexpr int NWAVES = 8;
constexpr int DM = 1024, NB = 2, SEQ = 8192, MP = NB * SEQ, DECB = 32, PAST = 8192, PAGE = 128, NPAGES = PAST / PAGE;
constexpr int HD = 64, NH = 8, DATT = 512, DIN = 3584, DFF = 4096, BLK = 256, NBLK = SEQ / BLK, CH = 64, NCH = SEQ / CH;
constexpr float EPS = 1e-6f;
constexpr float QSCALE = 0.125f * 1.4426950408889634f;
constexpr size_t O_YP = 0, O_YS = O_YP + (size_t)MP * DM, O_KP = O_YS + (size_t)DECB * DM, O_VP = O_KP + (size_t)MP * DATT, O_SP = O_VP + (size_t)MP * DATT,
                 O_KS = O_SP + (size_t)NB * NH * 64 * 64, O_VS = O_KS + (size_t)DECB * DATT, O_SS = O_VS + (size_t)DECB * DATT, O_END = O_SS + (size_t)DECB * NH * 64 * 64;
static_assert(O_END == 34734080, "d_out map");
constexpr size_t MiB = 1u << 20;
constexpr size_t WS_CTL = 0, CTL_ZERO_BYTES = 1 * MiB;
constexpr size_t WS_WIN = 2 * MiB, WS_WOUT = 9 * MiB, WS_WUP = 11 * MiB, WS_WDOWN = 19 * MiB;
constexpr size_t WS_ROPE = 27 * MiB;
constexpr size_t WS_SMALL = 28 * MiB;
constexpr size_t SM_XS = 0, SM_ZS = 65536, SM_MIXS = SM_ZS + 458752, SM_H1S = SM_MIXS + 65536, SM_HBS = SM_H1S + 131072, SM_UPS = SM_HBS + 65536, SM_H2S = SM_UPS + 262144, SM_LB = SM_H2S + 131072, SM_END = SM_LB + 2048;
static_assert(SM_END <= 2 * MiB, "small map");
constexpr size_t WS_KSUMS = 30 * MiB;
constexpr size_t WS_KPART = 34 * MiB;
constexpr size_t WS_SSQ1 = 35 * MiB, WS_SSQ2 = WS_SSQ1 + 512 * 1024;
constexpr size_t WS_LIST = 36 * MiB;
constexpr size_t WS_ML = 52 * MiB;
constexpr size_t WS_XN = 64 * MiB;
constexpr size_t WS_HB = 96 * MiB;
constexpr size_t WS_QA = 128 * MiB, WS_KA = 144 * MiB, WS_VA = 160 * MiB;
constexpr size_t WS_ZR = 176 * MiB;
constexpr size_t WS_OPART = 240 * MiB;
constexpr size_t WS_UP = 128 * MiB;
constexpr size_t WS_UT = 304 * MiB;
constexpr size_t WS_ST = 336 * MiB;
constexpr size_t WS_DC = 352 * MiB;
constexpr size_t WS_H1 = 354 * MiB;
constexpr size_t WS_END = 418 * MiB;
constexpr int CW_TMO = 0, CW_CODE = 1, CW_BAR = 4096, CW_TOT = 16384;
constexpr int RING_OFF = 0, RING_BYTES = 131072;
constexpr int LDSCTL_OFF = RING_BYTES, MISC_OFF = LDSCTL_OFF + 320;
constexpr int LDS_BYTES = 147456;

typedef float f32x16 __attribute__((ext_vector_type(16)));
typedef short s16x4 __attribute__((ext_vector_type(4)));
typedef unsigned u32x2 __attribute__((ext_vector_type(2)));
__device__ __forceinline__ float wave_sum(float v) {
#pragma unroll
    for (int o = 1; o < 64; o <<= 1) v += __shfl_xor(v, o);
    return v;
}
__device__ __forceinline__ float bf2f(unsigned short b) { return __builtin_bit_cast(float, (unsigned)b << 16); }
__device__ __forceinline__ float bflo(unsigned w) { return __builtin_bit_cast(float, w << 16); }
__device__ __forceinline__ float bfhi(unsigned w) { return __builtin_bit_cast(float, w & 0xffff0000u); }
#define MFMA16(a, b, c) __builtin_amdgcn_mfma_f32_16x16x32_bf16((a), (b), (c), 0, 0, 0)
#define MFMA32(a, b, c) __builtin_amdgcn_mfma_f32_32x32x16_bf16((a), (b), (c), 0, 0, 0)

struct Frame {
    LAS unsigned char* lds;
    volatile LAS unsigned* MISC;
    gu32* ctl;
    int tid, lane, wave, G;
    unsigned char* ws; float* out;
    const float *xp, *xs, *ck, *cv, *st0, *g1, *win, *lbl, *hg, *wout, *g2, *wup, *wdown, *gf; const int* pt;
};

__device__ __forceinline__ void p0_transpose_item(const float* W, int K, int N, bf16* WT, const float* gain, LAS float* scr, int item, int lane) {
    const int nblk = N / 32, kb = item / nblk, nb = item % nblk, k0 = 64 * kb, n0 = 32 * nb;
#pragma unroll 8
    for (int i = 0; i < 32; ++i) { const int kk = 2 * i + (lane >> 5); const float g = gain ? gain[k0 + kk] : 1.f; scr[kk * 33 + (lane & 31)] = W[(size_t)(k0 + kk) * N + n0 + (lane & 31)] * g; }
    LDS_WAIT(); asm volatile("" ::: "memory");
    const int c = lane & 7;
#pragma unroll
    for (int j = 0; j < 4; ++j) { const int n = (lane >> 3) + 8 * j; const LAS float* s = scr + (8 * c) * 33 + n;
        v4u o; o.x = pk2(s[0 * 33], s[1 * 33]); o.y = pk2(s[2 * 33], s[3 * 33]); o.z = pk2(s[4 * 33], s[5 * 33]); o.w = pk2(s[6 * 33], s[7 * 33]);
        *(GAS v4u*)(WT + (size_t)(n0 + n) * K + k0 + 8 * c) = o; }
    LDS_WAIT(); asm volatile("" ::: "memory");
}
__device__ __forceinline__ void rms_row_to_bf16(int lane, const float* xrow, bf16* orow) {
    const GAS f32x4* xr = (const GAS f32x4*)xrow + lane;
    f32x4 v[4]; float s = 0.f;
#pragma unroll
    for (int j = 0; j < 4; ++j) { v[j] = xr[64 * j]; s += (v[j].x * v[j].x + v[j].y * v[j].y) + (v[j].z * v[j].z + v[j].w * v[j].w); }
    const float rstd = 1.f / sqrtf(wave_sum(s) * (1.f / DM) + EPS);
    GAS unsigned long long* o8 = (GAS unsigned long long*)orow + lane;
#pragma unroll
    for (int j = 0; j < 4; ++j) o8[64 * j] = (unsigned long long)pk2(v[j].x * rstd, v[j].y * rstd) | ((unsigned long long)pk2(v[j].z * rstd, v[j].w * rstd) << 32);
}
__device__ __forceinline__ void sincos_d(double a, double& s, double& c) {
    const double q = rint(a * 0.6366197723675814);
    double r = fma(-q, 1.5707963267948966, a); r = fma(-q, 6.123233995736766e-17, r);
    const int qi = (int)q & 3; const double r2 = r * r;
    const double sp = r * (1.0 + r2 * (-1.0 / 6 + r2 * (1.0 / 120 + r2 * (-1.0 / 5040 + r2 * (1.0 / 362880 + r2 * (-1.0 / 39916800 + r2 * (1.0 / 6227020800.0)))))));
    const double cp = 1.0 + r2 * (-0.5 + r2 * (1.0 / 24 + r2 * (-1.0 / 720 + r2 * (1.0 / 40320 + r2 * (-1.0 / 3628800 + r2 * (1.0 / 479001600.0 + r2 * (-1.0 / 87178291200.0)))))));
    s = (qi == 0) ? sp : (qi == 1) ? cp : (qi == 2) ? -sp : -cp;
    c = (qi == 0) ? cp : (qi == 1) ? -sp : (qi == 2) ? -cp : sp;
}
__device__ __forceinline__ double rope_inv(int i) {
    return i == 0 ? 1.0 : i == 1 ? 0.1939227447486858 : i == 2 ? 0.03760603093086394 : i == 3 ? 0.007292664737217109 : i == 4 ? 0.0014142135623730955 : i == 5 ? 0.00027424817567620724 : i == 6 ? 5.318295896944988e-05 : 1.0313385377212461e-05;
}

__device__ __forceinline__ void p0_prologue(Frame& F) {
    LAS float* scr = (LAS float*)(F.lds + RING_OFF + F.wave * 16384);
    const int gw = blockIdx.x * NWAVES + F.wave, NGW = F.G * NWAVES;
    bf16* Win_t = (bf16*)(F.ws + WS_WIN); bf16* Wout_t = (bf16*)(F.ws + WS_WOUT); bf16* Wup_t = (bf16*)(F.ws + WS_WUP); bf16* Wdown_t = (bf16*)(F.ws + WS_WDOWN);
    constexpr int I_IN = (DM / 64) * (DIN / 32), I_OUT = (DM / 64) * (DM / 32), I_UP = (DM / 64) * (DFF / 32), I_DN = (DFF / 64) * (DM / 32);
    constexpr int NITEMS = I_IN + I_OUT + I_UP + I_DN;
    for (int it = gw; it < NITEMS; it += NGW) {
        int r = it;
        if (r < I_IN) { p0_transpose_item(F.win, DM, DIN, Win_t, F.g1, scr, r, F.lane); continue; } r -= I_IN;
        if (r < I_OUT) { p0_transpose_item(F.wout, DM, DM, Wout_t, nullptr, scr, r, F.lane); continue; } r -= I_OUT;
        if (r < I_UP) { p0_transpose_item(F.wup, DM, DFF, Wup_t, F.g2, scr, r, F.lane); continue; } r -= I_UP;
        p0_transpose_item(F.wdown, DFF, DM, Wdown_t, nullptr, scr, r, F.lane);
    }
    bf16* XN = (bf16*)(F.ws + WS_XN); bf16* XS = (bf16*)(F.ws + WS_SMALL + SM_XS);
    for (int m = gw; m < MP + DECB; m += NGW) { if (m < MP) rms_row_to_bf16(F.lane, F.xp + (size_t)m * DM, XN + (size_t)m * DM); else rms_row_to_bf16(F.lane, F.xs + (size_t)(m - MP) * DM, XS + (size_t)(m - MP) * DM); }
    float* rope = (float*)(F.ws + WS_ROPE);
    for (int e = blockIdx.x * (NWAVES * 64) + F.tid; e < (SEQ + 1) * 8; e += F.G * NWAVES * 64) { const int pos = e >> 3, i = e & 7; double s, c; sincos_d((double)pos * rope_inv(i), s, c); rope[pos * 16 + i] = (float)c; rope[pos * 16 + 8 + i] = (float)s; }
    float* LB = (float*)(F.ws + WS_SMALL + SM_LB);
    if (blockIdx.x == 0) { const int i = F.tid; const float l0 = F.lbl[i], l1 = F.lbl[512 + i]; LB[i] = 1.f / (1.f + expf(l1 - l0)); }
    float* KSUMS = (float*)(F.ws + WS_KSUMS);
    __syncthreads();
    LAS float* red = (LAS float*)(F.lds + RING_OFF);
    for (int it = blockIdx.x; it < DECB * NPAGES; it += F.G) {
        const int page = F.pt[it];
        const GAS f32x4* src = (const GAS f32x4*)(F.ck + (size_t)page * PAGE * DATT) + (size_t)(F.wave * 16) * 128 + F.lane;
        f32x4 a0 = {0.f, 0.f, 0.f, 0.f}, a1 = a0;
#pragma unroll
        for (int r = 0; r < 16; ++r) { a0 += src[r * 128]; a1 += src[r * 128 + 64]; }
        *(LAS f32x4*)(red + F.wave * 512 + 4 * F.lane) = a0; *(LAS f32x4*)(red + F.wave * 512 + 256 + 4 * F.lane) = a1;
        __syncthreads();
        float s = 0.f;
#pragma unroll
        for (int w = 0; w < 8; ++w) s += red[w * 512 + F.tid];
        KSUMS[(size_t)it * 512 + F.tid] = s;
        __syncthreads();
    }
}

__device__ __forceinline__ void skinny32(const bf16* A, int K, const bf16* Wt, int n0, LAS float* red  , LAS float* out  , int tid) {
    const int w = tid >> 6, lane = tid & 63, r = lane & 15, q = lane >> 4, kper = K / 8, k0 = w * kper;
    pg8::f32x4 acc0 = {0.f, 0.f, 0.f, 0.f}, acc1 = acc0;
    const bf16* wp = Wt + (size_t)(n0 + r) * K + k0 + 8 * q; const bf16* ap0 = A + (size_t)r * K + k0 + 8 * q; const bf16* ap1 = ap0 + (size_t)16 * K;
    for (int kk = 0; kk < kper; kk += 32) {
        const bf16x8 b = *(const GAS bf16x8*)(wp + kk), a0 = *(const GAS bf16x8*)(ap0 + kk), a1 = *(const GAS bf16x8*)(ap1 + kk);
        acc0 = MFMA16(a0, b, acc0); acc1 = MFMA16(a1, b, acc1);
    }
#pragma unroll
    for (int j = 0; j < 4; ++j) { red[w * 512 + (4 * q + j) * 16 + r] = acc0[j]; red[w * 512 + (16 + 4 * q + j) * 16 + r] = acc1[j]; }
    __syncthreads();
    { float s = 0.f;
#pragma unroll
      for (int ww = 0; ww < 8; ++ww) s += red[ww * 512 + tid];
      out[tid] = s; }
    __syncthreads();
}

struct EpiZ {
    static constexpr bool PERM = true, AFTER_DRAIN = false;
    bf16 *QA, *KA, *VA, *ZR; float *krows, *vrows, *kpart; const float* rope;
    __device__ __forceinline__ void operator()(const pg8::f32x4 (&acc)[2][2][4][2], const pg8::Unit& u, int wr, int wc, int fr, int fq) const {
        using pg8::f32x4; using pg8::u32x4; using pg8::cvt_pk_bf16;
        const int pn = u.pn, row0 = u.pm * 256 + wr * 64 + fr, cin = wc * 32 + 8 * fq;
        if (pn >= 6) {
            bf16* base = ZR + (pn - 6) * 256 + cin;
#pragma unroll
            for (int ai = 0; ai < 2; ++ai)
#pragma unroll
                for (int m = 0; m < 4; ++m) { bf16* rowp = base + (size_t)(row0 + ai * 128 + m * 16) * 2048;
#pragma unroll
                    for (int bj = 0; bj < 2; ++bj) { const f32x4 v0 = acc[ai][bj][m][0], v1 = acc[ai][bj][m][1]; u32x4 w; w.x = cvt_pk_bf16(v0[0], v0[1]); w.y = cvt_pk_bf16(v0[2], v0[3]); w.z = cvt_pk_bf16(v1[0], v1[1]); w.w = cvt_pk_bf16(v1[2], v1[3]);
                        *(u32x4*)(rowp + bj * 128) = w; } }
        } else if (pn >= 4) {
            bf16* base = VA + (pn - 4) * 256 + cin; float* fb = vrows + (pn - 4) * 256 + cin;
#pragma unroll
            for (int ai = 0; ai < 2; ++ai)
#pragma unroll
                for (int m = 0; m < 4; ++m) { const size_t ro = (size_t)(row0 + ai * 128 + m * 16) * 512;
#pragma unroll
                    for (int bj = 0; bj < 2; ++bj) { const f32x4 v0 = acc[ai][bj][m][0], v1 = acc[ai][bj][m][1]; u32x4 w; w.x = cvt_pk_bf16(v0[0], v0[1]); w.y = cvt_pk_bf16(v0[2], v0[3]); w.z = cvt_pk_bf16(v1[0], v1[1]); w.w = cvt_pk_bf16(v1[2], v1[3]);
                        *(u32x4*)(base + ro + bj * 128) = w; *(f32x4*)(fb + ro + bj * 128) = v0; *(f32x4*)(fb + ro + bj * 128 + 4) = v1; } }
        } else {
            const bool isk = pn >= 2; const int pc = (pn & 1) * 256 + cin;
            bf16* base = (isk ? KA : QA) + pc; float* fb = krows + pc;
            const bool rot = (wc & 1) == 0;
            const float sg = (fq == 0) ? -1.f : 1.f; const bool mine = rot && fq < 2; const float osc = isk ? 1.f : QSCALE;
            f32x4 cs[2][2];
#pragma unroll
            for (int bj = 0; bj < 2; ++bj) { cs[bj][0] = (f32x4){0.f, 0.f, 0.f, 0.f}; cs[bj][1] = cs[bj][0]; }
#pragma unroll
            for (int ai = 0; ai < 2; ++ai)
#pragma unroll
                for (int m = 0; m < 4; ++m) { const int row = row0 + ai * 128 + m * 16; const size_t ro = (size_t)row * 512;
                    f32x4 c0 = {1.f, 1.f, 1.f, 1.f}, c1 = c0, s0 = {0.f, 0.f, 0.f, 0.f}, s1 = s0;
                    if (rot) { const float* rp = rope + (size_t)(row & (SEQ - 1)) * 16; c0 = *(const f32x4*)rp; c1 = *(const f32x4*)(rp + 4); s0 = *(const f32x4*)(rp + 8); s1 = *(const f32x4*)(rp + 12); }
#pragma unroll
                    for (int bj = 0; bj < 2; ++bj) { f32x4 v0 = acc[ai][bj][m][0], v1 = acc[ai][bj][m][1];
                        if (rot) { f32x4 p0, p1;
#pragma unroll
                            for (int j = 0; j < 4; ++j) { p0[j] = __shfl_xor(v0[j], 16); p1[j] = __shfl_xor(v1[j], 16); }
                            if (mine) { v0 = v0 * c0 + p0 * s0 * sg; v1 = v1 * c1 + p1 * s1 * sg; } }
                        if (isk) { *(f32x4*)(fb + ro + bj * 128) = v0; *(f32x4*)(fb + ro + bj * 128 + 4) = v1; cs[bj][0] += v0; cs[bj][1] += v1; }
                        v0 = v0 * osc; v1 = v1 * osc;
                        u32x4 w; w.x = cvt_pk_bf16(v0[0], v0[1]); w.y = cvt_pk_bf16(v0[2], v0[3]); w.z = cvt_pk_bf16(v1[0], v1[1]); w.w = cvt_pk_bf16(v1[2], v1[3]);
                        *(u32x4*)(base + ro + bj * 128) = w; } }
            if (isk) {
#pragma unroll
                for (int bj = 0; bj < 2; ++bj)
#pragma unroll
                    for (int n = 0; n < 2; ++n)
#pragma unroll
                        for (int j = 0; j < 4; ++j) { float s = cs[bj][n][j]; s += __shfl_xor(s, 1); s += __shfl_xor(s, 2); s += __shfl_xor(s, 4); s += __shfl_xor(s, 8); cs[bj][n][j] = s; }
                if (fr == 0) { float* kp = kpart + (size_t)(u.pm * 2 + wr) * 512 + pc;
#pragma unroll
                    for (int bj = 0; bj < 2; ++bj) { *(f32x4*)(kp + bj * 128) = cs[bj][0]; *(f32x4*)(kp + bj * 128 + 4) = cs[bj][1]; } }
            }
        }
    }
};

__device__ __forceinline__ void gate_unit(Frame& F, int u) {
    const int b = u >> 7, j = (u >> 2) & 31, qq = u & 3, h = F.wave, t = j * BLK + qq * 64 + F.lane;
    if (j == 0) return;
    LAS float* km = (LAS float*)(F.lds + RING_OFF);
    const float* kpart = (const float*)(F.ws + WS_KPART);
    for (int idx = F.tid; idx < j * 512; idx += NWAVES * 64) { const int n = idx >> 9, c = idx & 511; const float* p = kpart + (size_t)((b * NBLK + n) * 2) * 512 + c; km[idx] = p[0] + p[512]; }
    __syncthreads();
    const bf16* qrow = (const bf16*)(F.ws + WS_QA) + (size_t)(b * SEQ + t) * DATT + h * HD;
    float q[64];
#pragma unroll
    for (int c = 0; c < 8; ++c) { const v4u w = *(const GAS v4u*)(qrow + 8 * c); q[8 * c] = bflo(w.x); q[8 * c + 1] = bfhi(w.x); q[8 * c + 2] = bflo(w.y); q[8 * c + 3] = bfhi(w.y); q[8 * c + 4] = bflo(w.z); q[8 * c + 5] = bfhi(w.z); q[8 * c + 6] = bflo(w.w); q[8 * c + 7] = bfhi(w.w); }
    float v0 = -INFINITY, v1 = -INFINITY, v2 = -INFINITY; int i0 = -1, i1 = -1, i2 = -1;
    for (int n = 0; n < j; ++n) {
        const LAS f32x4* kp = (const LAS f32x4*)(km + n * 512 + h * HD);
        float d0 = 0.f, d1 = 0.f, d2 = 0.f, d3 = 0.f;
#pragma unroll
        for (int c = 0; c < 16; ++c) { const f32x4 kv = kp[c]; d0 += q[4 * c] * kv.x; d1 += q[4 * c + 1] * kv.y; d2 += q[4 * c + 2] * kv.z; d3 += q[4 * c + 3] * kv.w; }
        const float g = (d0 + d1) + (d2 + d3);
        if (g > v0) { v2 = v1; i2 = i1; v1 = v0; i1 = i0; v0 = g; i0 = n; }
        else if (g > v1) { v2 = v1; i2 = i1; v1 = g; i1 = n; }
        else if (g > v2) { v2 = g; i2 = n; }
    }
    unsigned* LIST = (unsigned*)(F.ws + WS_LIST);
    const unsigned long long ltmask = (1ull << F.lane) - 1ull;
    for (int n = 0; n < j; ++n) {
        const bool sel = (i0 == n) || (i1 == n) || (i2 == n);
        const unsigned long long mask = __ballot(sel);
        if (mask == 0ull) continue;
        const int cnt = __popcll(mask);
        const int li = (b * NH + h) * NBLK + n;
        unsigned off = 0u;
        if (F.lane == 0) off = __hip_atomic_fetch_add(F.ctl + CW_TOT + li, (unsigned)cnt, __ATOMIC_RELAXED, __HIP_MEMORY_SCOPE_AGENT);
        off = __builtin_amdgcn_readfirstlane(off);
        if (sel) { const int slot = (i0 == n) ? 0 : (i1 == n) ? 1 : 2; LIST[(size_t)li * 8192 + off + __popcll(mask & ltmask)] = (unsigned)t | ((unsigned)slot << 16); }
    }
}

typedef short v4i16_t __attribute__((ext_vector_type(4)));
__device__ __forceinline__ int img_off(int row, int ch) { const int g = ((row >> 1) & 1) | (((row >> 3) & 1) << 1); return row * 128 + 16 * (ch ^ (g << 1)); }
__device__ __forceinline__ s16x4 tr_read(LAS unsigned char* p) { return __builtin_bit_cast(s16x4, __builtin_amdgcn_ds_read_tr16_b64_v4i16((LAS v4i16_t*)p)); }
__device__ __forceinline__ bf16x8 tr_frag(LAS unsigned char* img, int R0, int tile, int lane) {
    const int q = lane >> 4, i16 = lane & 15, qp = i16 >> 2, p = i16 & 3;
    const int r0 = R0 + 8 * q + qp, ch = 2 * tile + (p >> 1), bo = 8 * (p & 1);
    const s16x4 lo = tr_read(img + img_off(r0, ch) + bo), hi = tr_read(img + img_off(r0 + 4, ch) + bo);
    return __builtin_shufflevector(lo, hi, 0, 1, 2, 3, 4, 5, 6, 7);
}
__device__ __forceinline__ bf16x8 row_frag(LAS unsigned char* img, int ks, int tile, int lane) {
    const int q = lane >> 4, r = 16 * tile + (lane & 15);
    return *(const LAS bf16x8*)(img + img_off(r, 4 * ks + q));
}
__device__ __forceinline__ float sigmoidf_(float x) { return 1.f / (1.f + __expf(-x)); }

__device__ __forceinline__ void hgrn_h1(Frame& F, int id) {
    const int bh = id >> 7, c = id & 127, b = bh >> 3, h = bh & 7, lane = F.lane;
    LAS unsigned char* KL = F.lds + RING_OFF + F.wave * 16384; LAS unsigned char* VI = KL + 8192;
    const bf16* zr = (const bf16*)(F.ws + WS_ZR) + (size_t)(b * SEQ + c * CH) * 2048;
    const float lb = ((const float*)(F.ws + WS_SMALL + SM_LB))[h * 64 + lane];
    const bf16* fp = zr + 512 + h * 64 + lane;
    float bl = 0.f;
#pragma unroll 8
    for (int t = 0; t < CH; ++t) { const float f = lb + (1.f - lb) * sigmoidf_(bf2f(fp[(size_t)t * 2048])); bl += __log2f(f); }
    float bc = 0.f;
#pragma unroll 8
    for (int t = 0; t < CH; ++t) { const float f = lb + (1.f - lb) * sigmoidf_(bf2f(fp[(size_t)t * 2048])); bc += __log2f(f);
        const float kl = (1.f - f) * exp2f(bl - bc);
        *(LAS unsigned short*)(KL + img_off(t, lane >> 3) + 2 * (lane & 7)) = (unsigned short)f2bf(kl); }
    const bf16* vp = zr + 1024 + h * 64;
#pragma unroll
    for (int i = 0; i < 8; ++i) { const int idc = lane + 64 * i, row = idc >> 3, ch = idc & 7; *(LAS v4u*)(VI + img_off(row, ch)) = *(const GAS v4u*)(vp + (size_t)row * 2048 + 8 * ch); }
    LDS_WAIT(); asm volatile("" ::: "memory");
    float* UT = (float*)(F.ws + WS_UT) + (size_t)(bh * NCH + c) * 4096;
    ((float*)(F.ws + WS_DC))[(size_t)(bh * NCH + c) * 64 + lane] = exp2f(bl);
    const int q = lane >> 4, r = lane & 15;
#pragma unroll
    for (int vt = 0; vt < 4; ++vt) {
        const bf16x8 a0 = tr_frag(VI, 0, vt, lane), a1 = tr_frag(VI, 32, vt, lane);
#pragma unroll
        for (int kt = 0; kt < 4; ++kt) {
            const bf16x8 b0 = tr_frag(KL, 0, kt, lane), b1 = tr_frag(KL, 32, kt, lane);
            pg8::f32x4 acc = {0.f, 0.f, 0.f, 0.f};
            acc = MFMA16(a0, b0, acc); acc = MFMA16(a1, b1, acc);
#pragma unroll
            for (int jj = 0; jj < 4; ++jj) UT[(16 * vt + 4 * q + jj) * 64 + 16 * kt + r] = acc[jj];
        }
    }
    LDS_WAIT(); asm volatile("" ::: "memory");
}

__device__ __forceinline__ void sample_attn_unit(Frame& F, int u) {
    const int b = u >> 3, h = u & 7, tid = F.tid, lane = F.lane, w = F.wave;
    LAS float* sh = (LAS float*)(F.lds + RING_OFF);
    LAS float* qs = sh;
    LAS float* gate = sh + 64;
    LAS int* selp = (LAS int*)(sh + 96);
    LAS float* pbuf = sh + 128;
    LAS float* wred = sh + 1024;
    const float* zs = (const float*)(F.ws + WS_SMALL + SM_ZS) + (size_t)b * DIN;
    const float* rp = (const float*)(F.ws + WS_ROPE) + (size_t)PAST * 16;
    if (tid < 128) {
        const int isk = tid >> 6, d = tid & 63; const float* src = zs + isk * 512 + h * 64;
        float v = src[d];
        if (d < 16) { const int i = d & 7; const float c = rp[i], s = rp[8 + i]; v = (d < 8) ? v * c - src[d + 8] * s : v * c + src[d - 8] * s; }
        if (isk) F.out[O_KS + (size_t)b * DATT + h * 64 + d] = v; else qs[d] = v * QSCALE;
        if (isk) sh[1600 + d] = v;
    } else if (tid < 192) { const int d = tid - 128; const float v = zs[1024 + h * 64 + d]; F.out[O_VS + (size_t)b * DATT + h * 64 + d] = v; sh[1664 + d] = v; }
    __syncthreads();
    if (tid < 256) { const int n = tid >> 3, part = tid & 7; const float* ks = (const float*)(F.ws + WS_KSUMS) + (size_t)(b * NPAGES + 2 * n) * 512 + h * 64 + part * 8; float s = 0.f;
#pragma unroll
        for (int d = 0; d < 8; ++d) s += qs[part * 8 + d] * (ks[d] + ks[512 + d]);
        s += __shfl_xor(s, 1); s += __shfl_xor(s, 2); s += __shfl_xor(s, 4);
        if (part == 0) gate[n] = s; }
    __syncthreads();
    if (tid == 0) { float v0 = -INFINITY, v1 = -INFINITY, v2 = -INFINITY; int i0 = 0, i1 = 0, i2 = 0;
        for (int n = 0; n < 32; ++n) { const float g = gate[n];
            if (g > v0) { v2 = v1; i2 = i1; v1 = v0; i1 = i0; v0 = g; i0 = n; } else if (g > v1) { v2 = v1; i2 = i1; v1 = g; i1 = n; } else if (g > v2) { v2 = g; i2 = n; } }
        selp[0] = i0; selp[1] = i1; selp[2] = i2;
        selp[4] = F.pt[b * NPAGES + 2 * i0]; selp[5] = F.pt[b * NPAGES + 2 * i0 + 1]; selp[6] = F.pt[b * NPAGES + 2 * i1]; selp[7] = F.pt[b * NPAGES + 2 * i1 + 1]; selp[8] = F.pt[b * NPAGES + 2 * i2]; selp[9] = F.pt[b * NPAGES + 2 * i2 + 1]; }
    __syncthreads();
    { const int sub = lane & 3, kq = lane >> 2;
      f32x4 qv[4];
#pragma unroll
      for (int i = 0; i < 4; ++i) qv[i] = *(const LAS f32x4*)(qs + sub * 16 + 4 * i);
#pragma unroll
      for (int pass = 0; pass < 6; ++pass) { const int key = 96 * w + 16 * pass + kq, kin = key & 255;
          const int page = selp[4 + (key >> 7)];
          const GAS f32x4* kp = (const GAS f32x4*)(F.ck + ((size_t)page * PAGE + (kin & 127)) * DATT + h * 64 + sub * 16);
          float s = 0.f;
#pragma unroll
          for (int i = 0; i < 4; ++i) { const f32x4 kv = kp[i]; s += qv[i].x * kv.x + qv[i].y * kv.y + qv[i].z * kv.z + qv[i].w * kv.w; }
          s += __shfl_xor(s, 1); s += __shfl_xor(s, 2);
          if (sub == 0) pbuf[key] = s; } }
    __syncthreads();
    float sself = 0.f;
#pragma unroll 8
    for (int d = 0; d < 64; ++d) sself += qs[d] * sh[1600 + d];
    float mx = sself;
    for (int i = lane; i < 768; i += 64) mx = fmaxf(mx, pbuf[i]);
#pragma unroll
    for (int o = 1; o < 64; o <<= 1) mx = fmaxf(mx, __shfl_xor(mx, o));
    __syncthreads();
    for (int i = tid; i < 768; i += NWAVES * 64) pbuf[i] = exp2f(pbuf[i] - mx);
    __syncthreads();
    float lsum = 0.f;
    for (int i = lane; i < 768; i += 64) lsum += pbuf[i];
    lsum = wave_sum(lsum);
    const float pself = exp2f(sself - mx); lsum += pself;
    float o = 0.f;
#pragma unroll 16
    for (int kk = 0; kk < 96; ++kk) { const int key = 96 * w + kk, kin = key & 255;
        const int page = selp[4 + (key >> 7)];
        o += pbuf[key] * F.cv[((size_t)page * PAGE + (kin & 127)) * DATT + h * 64 + lane]; }
    wred[w * 64 + lane] = o;
    __syncthreads();
    if (tid < 64) { float s = pself * sh[1664 + tid];
#pragma unroll
        for (int ww = 0; ww < 8; ++ww) s += wred[ww * 64 + tid];
        ((bf16*)(F.ws + WS_SMALL + SM_MIXS))[(size_t)b * DM + h * 64 + tid] = (bf16)f2bf(s / lsum); }
    __syncthreads();
}

__device__ __forceinline__ void sample_hgrn(Frame& F, int id) {
    const int b = id >> 3, h = id & 7, lane = F.lane;
    const float* zs = (const float*)(F.ws + WS_SMALL + SM_ZS) + (size_t)b * DIN;
    const float* LB = (const float*)(F.ws + WS_SMALL + SM_LB) + h * 64;
    const float* S0 = F.st0 + (size_t)(b * NH + h) * 4096; float* S1 = F.out + O_SS + (size_t)(b * NH + h) * 4096;
    const float iv = zs[2560 + h * 64 + lane];
    float o = 0.f;
#pragma unroll 8
    for (int k = 0; k < 64; ++k) { const float lb = LB[k], f = lb + (1.f - lb) * sigmoidf_(zs[2048 + h * 64 + k]); const float s = f * S0[k * 64 + lane] + (1.f - f) * iv; S1[k * 64 + lane] = s; o += s * zs[1536 + h * 64 + k]; }
    const float ms = wave_sum(o * o) * (1.f / 64.f); const float g = zs[3072 + h * 64 + lane];
    const float y = o * (1.f / sqrtf(ms + EPS)) * F.hg[lane] * (g * sigmoidf_(g));
    ((bf16*)(F.ws + WS_SMALL + SM_MIXS))[(size_t)b * DM + 512 + h * 64 + lane] = (bf16)f2bf(y);
}

constexpr int KSTR = 144, VSTR = 192;
constexpr int ATT_K = 0, ATT_V = 256 * KSTR, ATT_TAB = ATT_V + 256 * VSTR, ATT_END = ATT_TAB + 4096;
static_assert(ATT_END <= RING_BYTES, "attention LDS");
constexpr int TPU = 16;
typedef float f32x2_t __attribute__((ext_vector_type(2))); typedef __bf16 bf16x2_t __attribute__((ext_vector_type(2)));
__device__ __forceinline__ unsigned pkbf(float lo, float hi) { const f32x2_t v = {lo, hi}; const bf16x2_t b = __builtin_convertvector(v, bf16x2_t); return __builtin_bit_cast(unsigned, b); }

__device__ __forceinline__ int att_build_table(Frame& F) {
    LAS int* tab = (LAS int*)(F.lds + RING_OFF + ATT_TAB);
    LAS int* wsum = tab + 520;
    const int idx = F.tid, n = idx >> 4, bh = idx & 15;
    const int cnt = (int)__hip_atomic_load(F.ctl + CW_TOT + bh * NBLK + n, __ATOMIC_RELAXED, __HIP_MEMORY_SCOPE_AGENT);
    const int ntile = 8 + ((cnt + 31) >> 5), nu = (ntile + TPU - 1) / TPU;
    int inc = nu;
#pragma unroll
    for (int o = 1; o < 64; o <<= 1) { const int x = __shfl_up(inc, o); if (F.lane >= o) inc += x; }
    if (F.lane == 63) wsum[F.wave] = inc;
    __syncthreads();
    int base = 0;
    for (int w = 0; w < F.wave; ++w) base += wsum[w];
    tab[idx + 1] = base + inc; if (idx == 0) tab[0] = 0;
    __syncthreads();
    return tab[512];
}

__device__ __forceinline__ void attn_unit(Frame& F, int u) {
    LAS unsigned char* lds = F.lds + RING_OFF;
    LAS int* tab = (LAS int*)(lds + ATT_TAB);
    int lo = 0, hi = 512;
    while (hi - lo > 1) { const int mid = (lo + hi) >> 1; if (tab[mid] <= u) lo = mid; else hi = mid; }
    const int idx = lo, n = idx >> 4, bh = idx & 15, b = bh >> 3, head = bh & 7, li = bh * NBLK + n;
    const int cnt = (int)__hip_atomic_load(F.ctl + CW_TOT + li, __ATOMIC_RELAXED, __HIP_MEMORY_SCOPE_AGENT);
    const int ntile = 8 + ((cnt + 31) >> 5), tile0 = (u - tab[idx]) * TPU, tile1 = min(tile0 + TPU, ntile);
    const int lane = F.lane, r = lane & 31, hh = lane >> 5;
    { const bf16* kb = (const bf16*)(F.ws + WS_KA) + (size_t)(b * SEQ + n * BLK) * DATT + head * HD; const bf16* vb = (const bf16*)(F.ws + WS_VA) + (size_t)(b * SEQ + n * BLK) * DATT + head * HD;
#pragma unroll
      for (int i = 0; i < 4; ++i) { const int id = F.tid + 512 * i, row = id >> 3, ch = id & 7;
          const v4u kv = *(const GAS v4u*)(kb + (size_t)row * DATT + 8 * ch), vv = *(const GAS v4u*)(vb + (size_t)row * DATT + 8 * ch);
          *(LAS v4u*)(lds + ATT_K + row * KSTR + 16 * ch) = kv; *(LAS v4u*)(lds + ATT_V + row * VSTR + 16 * ch) = vv; } }
    __syncthreads();
    const unsigned* LIST = (const unsigned*)(F.ws + WS_LIST) + (size_t)li * 8192;
    const bf16* QA = (const bf16*)(F.ws + WS_QA);
    for (int ti = tile0 + F.wave; ti < tile1; ti += NWAVES) {
        int t, slot; bool valid = true;
        const bool diag = ti < 8;
        if (diag) { t = n * BLK + 32 * ti + r; slot = 3; }
        else { const int e = 32 * (ti - 8) + r; valid = e < cnt; const unsigned ent = LIST[valid ? e : (cnt - 1)]; t = (int)(ent & 0xffffu); slot = (int)(ent >> 16); }
        const bf16* qp = QA + (size_t)(b * SEQ + t) * DATT + head * HD + 8 * hh;
        bf16x8 qf[4];
#pragma unroll
        for (int ks = 0; ks < 4; ++ks) qf[ks] = *(const GAS bf16x8*)(qp + 16 * ks);
        f32x16 s[8];
        { const LAS unsigned char* kr = lds + ATT_K + r * KSTR + 16 * hh;
          bf16x8 kf[4], kn[4];
#pragma unroll
          for (int ks = 0; ks < 4; ++ks) kf[ks] = *(const LAS bf16x8*)(kr + 32 * ks);
#pragma unroll
          for (int kg = 0; kg < 8; ++kg) {
              if (kg < 7) {
#pragma unroll
                  for (int ks = 0; ks < 4; ++ks) kn[ks] = *(const LAS bf16x8*)(kr + (32 * (kg + 1)) * KSTR + 32 * ks); }
              f32x16 a = {0.f, 0.f, 0.f, 0.f, 0.f, 0.f, 0.f, 0.f, 0.f, 0.f, 0.f, 0.f, 0.f, 0.f, 0.f, 0.f};
#pragma unroll
              for (int ks = 0; ks < 4; ++ks) a = MFMA32(kf[ks], qf[ks], a);
              s[kg] = a;
#pragma unroll
              for (int ks = 0; ks < 4; ++ks) kf[ks] = kn[ks];
              __builtin_amdgcn_sched_barrier(0);
          } }
        if (diag) { const int qlh = 32 * ti + r - 4 * hh;
#pragma unroll
            for (int kg = 0; kg < 8; ++kg)
#pragma unroll
                for (int i = 0; i < 16; ++i) { if (32 * kg + (i & 3) + 8 * (i >> 2) > qlh) s[kg][i] = -1e30f; } }
        float m = s[0][0];
#pragma unroll
        for (int kg = 0; kg < 8; ++kg)
#pragma unroll
            for (int i = 0; i < 16; ++i) m = fmaxf(m, s[kg][i]);
        m = fmaxf(m, __shfl_xor(m, 32));
        float l = 0.f;
#pragma unroll
        for (int kg = 0; kg < 8; ++kg)
#pragma unroll
            for (int i = 0; i < 16; ++i) { const float p = __builtin_amdgcn_exp2f(s[kg][i] - m); s[kg][i] = p; l += p; }
        l += __shfl_xor(l, 32);
        f32x16 o0 = {0.f, 0.f, 0.f, 0.f, 0.f, 0.f, 0.f, 0.f, 0.f, 0.f, 0.f, 0.f, 0.f, 0.f, 0.f, 0.f}, o1 = o0;
        const int g16 = lane >> 4, i16 = lane & 15, qp4 = i16 >> 2, p4 = i16 & 3;
        const LAS unsigned char* vbase = lds + ATT_V + (4 * (g16 >> 1) + qp4) * VSTR + (16 * (g16 & 1) + 4 * p4) * 2;
        { s16x4 va[4], vn[4];
          va[0] = tr_read((LAS unsigned char*)vbase); va[1] = tr_read((LAS unsigned char*)(vbase + 8 * VSTR)); va[2] = tr_read((LAS unsigned char*)(vbase + 64)); va[3] = tr_read((LAS unsigned char*)(vbase + 8 * VSTR + 64));
#pragma unroll
          for (int it = 0; it < 16; ++it) { const int kg = it >> 1, st = it & 1;
              if (it < 15) { const LAS unsigned char* vk = vbase + (16 * (it + 1)) * VSTR;
                  vn[0] = tr_read((LAS unsigned char*)vk); vn[1] = tr_read((LAS unsigned char*)(vk + 8 * VSTR)); vn[2] = tr_read((LAS unsigned char*)(vk + 64)); vn[3] = tr_read((LAS unsigned char*)(vk + 8 * VSTR + 64)); }
              pg8::u32x4 pw; pw.x = pkbf(s[kg][8 * st], s[kg][8 * st + 1]); pw.y = pkbf(s[kg][8 * st + 2], s[kg][8 * st + 3]); pw.z = pkbf(s[kg][8 * st + 4], s[kg][8 * st + 5]); pw.w = pkbf(s[kg][8 * st + 6], s[kg][8 * st + 7]);
              const bf16x8 pf = __builtin_bit_cast(bf16x8, pw);
              o0 = MFMA32(__builtin_shufflevector(va[0], va[1], 0, 1, 2, 3, 4, 5, 6, 7), pf, o0);
              o1 = MFMA32(__builtin_shufflevector(va[2], va[3], 0, 1, 2, 3, 4, 5, 6, 7), pf, o1);
#pragma unroll
              for (int x = 0; x < 4; ++x) va[x] = vn[x];
              __builtin_amdgcn_sched_barrier(0);
          } }
        if (valid) {
            const size_t qh = (size_t)(b * SEQ + t) * NH + head;
            bf16* op = (bf16*)(F.ws + WS_OPART) + (qh * 4 + slot) * 64 + 4 * hh;
#pragma unroll
            for (int g = 0; g < 4; ++g) { u32x2 w0, w1; w0.x = pkbf(o0[4 * g], o0[4 * g + 1]); w0.y = pkbf(o0[4 * g + 2], o0[4 * g + 3]); w1.x = pkbf(o1[4 * g], o1[4 * g + 1]); w1.y = pkbf(o1[4 * g + 2], o1[4 * g + 3]);
                *(GAS u32x2*)(op + 8 * g) = w0; *(GAS u32x2*)(op + 32 + 8 * g) = w1; }
            if (hh == 0) { float* ml = (float*)(F.ws + WS_ML) + (qh * 4 + slot) * 2; ml[0] = m; ml[1] = l; }
        }
    }
    __syncthreads();
}

__device__ __forceinline__ void scan_unit(Frame& F, int s) {
    const int e = s * 512 + F.tid, bh = e >> 12, v = (e >> 6) & 63, k = e & 63;
    const float* up = (const float*)(F.ws + WS_UT) + (size_t)bh * NCH * 4096 + v * 64 + k;
    const float* dp = (const float*)(F.ws + WS_DC) + (size_t)bh * NCH * 64 + k;
    bf16* sp = (bf16*)(F.ws + WS_ST) + (size_t)bh * NCH * 4096 + v * 64 + k;
    float S = 0.f;
    for (int c0 = 0; c0 < NCH; c0 += 16) {
        float uu[16], dd[16];
#pragma unroll
        for (int i = 0; i < 16; ++i) { uu[i] = up[(size_t)(c0 + i) * 4096]; dd[i] = dp[(c0 + i) * 64]; }
#pragma unroll
        for (int i = 0; i < 16; ++i) { sp[(size_t)(c0 + i) * 4096] = (bf16)f2bf(S); S = dd[i] * S + uu[i]; }
    }
    F.out[O_SP + (size_t)bh * 4096 + k * 64 + v] = S;
}

__device__ __forceinline__ void hgrn_h3(Frame& F, int id) {
    const int bh = id >> 7, c = id & 127, b = bh >> 3, h = bh & 7, lane = F.lane, q = lane >> 4, r = lane & 15;
    LAS unsigned char* QD = F.lds + RING_OFF + F.wave * 16384; LAS unsigned char* KD = QD + 8192;
    const size_t row0 = (size_t)(b * SEQ + c * CH);
    const bf16* zr = (const bf16*)(F.ws + WS_ZR) + row0 * 2048;
    const float lb = ((const float*)(F.ws + WS_SMALL + SM_LB))[h * 64 + lane];
    const bf16* fp = zr + 512 + h * 64 + lane; const bf16* qp = zr + h * 64 + lane;
    float bc = 0.f;
#pragma unroll 8
    for (int t = 0; t < CH; ++t) { const float f = lb + (1.f - lb) * sigmoidf_(bf2f(fp[(size_t)t * 2048])); bc += __log2f(f);
        const float qd = bf2f(qp[(size_t)t * 2048]) * exp2f(bc), kd = (1.f - f) * exp2f(-bc);
        const int o = img_off(t, lane >> 3) + 2 * (lane & 7);
        *(LAS unsigned short*)(QD + o) = (unsigned short)f2bf(qd); *(LAS unsigned short*)(KD + o) = (unsigned short)f2bf(kd); }
    LDS_WAIT(); asm volatile("" ::: "memory");
    unsigned Ap[4][4][2];
#pragma unroll
    for (int st = 0; st < 4; ++st) {
        const bf16x8 k0 = row_frag(KD, 0, st, lane), k1 = row_frag(KD, 1, st, lane);
#pragma unroll
        for (int tt = 0; tt < 4; ++tt) { Ap[st][tt][0] = 0u; Ap[st][tt][1] = 0u;
            if (tt >= st) { pg8::f32x4 acc = {0.f, 0.f, 0.f, 0.f}; acc = MFMA16(k0, row_frag(QD, 0, tt, lane), acc); acc = MFMA16(k1, row_frag(QD, 1, tt, lane), acc);
                if (st == tt) {
#pragma unroll
                    for (int j = 0; j < 4; ++j) if (4 * q + j > r) acc[j] = 0.f; }
                Ap[st][tt][0] = pkbf(acc[0], acc[1]); Ap[st][tt][1] = pkbf(acc[2], acc[3]); } }
    }
    pg8::f32x4 o[4][4];
    const bf16* ST = (const bf16*)(F.ws + WS_ST) + (size_t)(bh * NCH + c) * 4096;
#pragma unroll
    for (int vt = 0; vt < 4; ++vt) {
        const bf16x8 s0 = *(const GAS bf16x8*)(ST + (size_t)(16 * vt + r) * 64 + 8 * q), s1 = *(const GAS bf16x8*)(ST + (size_t)(16 * vt + r) * 64 + 32 + 8 * q);
#pragma unroll
        for (int tt = 0; tt < 4; ++tt) { pg8::f32x4 acc = {0.f, 0.f, 0.f, 0.f}; acc = MFMA16(s0, row_frag(QD, 0, tt, lane), acc); acc = MFMA16(s1, row_frag(QD, 1, tt, lane), acc); o[vt][tt] = acc; }
    }
    LDS_WAIT(); asm volatile("" ::: "memory");
    const bf16* vp = zr + 1024 + h * 64;
#pragma unroll
    for (int i = 0; i < 8; ++i) { const int idc = lane + 64 * i, row = idc >> 3, ch = idc & 7; *(LAS v4u*)(QD + img_off(row, ch)) = *(const GAS v4u*)(vp + (size_t)row * 2048 + 8 * ch); }
    LDS_WAIT(); asm volatile("" ::: "memory");
    { const int i16 = lane & 15, qp4 = i16 >> 2, p4 = i16 & 3;
#pragma unroll
      for (int m = 0; m < 2; ++m)
#pragma unroll
        for (int vt = 0; vt < 4; ++vt) {
            const int r0 = 32 * m + 4 * q + qp4, ch = 2 * vt + (p4 >> 1), bo = 8 * (p4 & 1);
            const s16x4 lo = tr_read(QD + img_off(r0, ch) + bo), hi = tr_read(QD + img_off(r0 + 16, ch) + bo);
            const bf16x8 af = __builtin_shufflevector(lo, hi, 0, 1, 2, 3, 4, 5, 6, 7);
#pragma unroll
            for (int tt = 2 * m; tt < 4; ++tt) { pg8::u32x4 bw; bw.x = Ap[2 * m][tt][0]; bw.y = Ap[2 * m][tt][1]; bw.z = Ap[2 * m + 1][tt][0]; bw.w = Ap[2 * m + 1][tt][1];
                o[vt][tt] = MFMA16(af, __builtin_bit_cast(bf16x8, bw), o[vt][tt]); }
        } }
    bf16* mix = (bf16*)(F.ws + WS_XN) + row0 * DM + 512 + h * 64 + 4 * q; const bf16* gp = zr + 1536 + h * 64 + 4 * q;
    f32x4 gv[4];
#pragma unroll
    for (int vt = 0; vt < 4; ++vt) gv[vt] = *(const GAS f32x4*)(F.hg + 16 * vt + 4 * q);
#pragma unroll
    for (int tt = 0; tt < 4; ++tt) { float ss = 0.f;
#pragma unroll
        for (int vt = 0; vt < 4; ++vt) ss += (o[vt][tt][0] * o[vt][tt][0] + o[vt][tt][1] * o[vt][tt][1]) + (o[vt][tt][2] * o[vt][tt][2] + o[vt][tt][3] * o[vt][tt][3]);
        ss += __shfl_xor(ss, 16); ss += __shfl_xor(ss, 32);
        const float rstd = 1.f / sqrtf(ss * (1.f / 64.f) + EPS); const int t = 16 * tt + r;
#pragma unroll
        for (int vt = 0; vt < 4; ++vt) { const u32x2 gw = *(const GAS u32x2*)(gp + (size_t)t * 2048 + 16 * vt);
            const float g0 = bflo(gw.x), g1 = bfhi(gw.x), g2 = bflo(gw.y), g3 = bfhi(gw.y);
            u32x2 w; w.x = pk2(o[vt][tt][0] * rstd * gv[vt].x * (g0 * sigmoidf_(g0)), o[vt][tt][1] * rstd * gv[vt].y * (g1 * sigmoidf_(g1)));
            w.y = pk2(o[vt][tt][2] * rstd * gv[vt].z * (g2 * sigmoidf_(g2)), o[vt][tt][3] * rstd * gv[vt].w * (g3 * sigmoidf_(g3)));
            *(GAS u32x2*)(mix + (size_t)t * DM + 16 * vt) = w; } }
    LDS_WAIT(); asm volatile("" ::: "memory");
}

__device__ __forceinline__ void combine_items(Frame& F) {
    const bf16* OP = (const bf16*)(F.ws + WS_OPART); const float* ML = (const float*)(F.ws + WS_ML); bf16* mix = (bf16*)(F.ws + WS_XN);
    for (int it = blockIdx.x * (NWAVES * 64) + F.tid; it < MP * NH * 8; it += F.G * NWAVES * 64) {
        const int qh = it >> 3, g8 = it & 7, row = qh >> 3, head = qh & 7, t = row & (SEQ - 1), nsel = min(3, t >> 8);
        const f32x4 ml0 = *(const GAS f32x4*)(ML + (size_t)qh * 8), ml1 = *(const GAS f32x4*)(ML + (size_t)qh * 8 + 4);
        const float m0 = nsel > 0 ? ml0.x : -1e30f, m1 = nsel > 1 ? ml0.z : -1e30f, m2 = nsel > 2 ? ml1.x : -1e30f, m3 = ml1.z;
        const float M = fmaxf(fmaxf(m0, m1), fmaxf(m2, m3));
        const float w0 = nsel > 0 ? exp2f(m0 - M) : 0.f, w1 = nsel > 1 ? exp2f(m1 - M) : 0.f, w2 = nsel > 2 ? exp2f(m2 - M) : 0.f, w3 = exp2f(m3 - M);
        const float L = (nsel > 0 ? w0 * ml0.y : 0.f) + (nsel > 1 ? w1 * ml0.w : 0.f) + (nsel > 2 ? w2 * ml1.y : 0.f) + w3 * ml1.w;
        const float inv = 1.f / L;
        float acc[8] = {0.f, 0.f, 0.f, 0.f, 0.f, 0.f, 0.f, 0.f};
        const bf16* op = OP + (size_t)qh * 256 + 8 * g8;
#pragma unroll
        for (int sl = 0; sl < 4; ++sl) { const float w = sl == 0 ? w0 : sl == 1 ? w1 : sl == 2 ? w2 : w3;
            if (sl == 3 || sl < nsel) { const v4u x = *(const GAS v4u*)(op + sl * 64);
                acc[0] += w * bflo(x.x); acc[1] += w * bfhi(x.x); acc[2] += w * bflo(x.y); acc[3] += w * bfhi(x.y); acc[4] += w * bflo(x.z); acc[5] += w * bfhi(x.z); acc[6] += w * bflo(x.w); acc[7] += w * bfhi(x.w); } }
        v4u o; o.x = pk2(acc[0] * inv, acc[1] * inv); o.y = pk2(acc[2] * inv, acc[3] * inv); o.z = pk2(acc[4] * inv, acc[5] * inv); o.w = pk2(acc[6] * inv, acc[7] * inv);
        *(GAS v4u*)(mix + (size_t)row * DM + head * 64 + 8 * g8) = o;
    }
}

struct EpiOut {
    static constexpr bool PERM = false, AFTER_DRAIN = true;
    const float* base; float* h1; bf16* hb; float* ssq;
    __device__ __forceinline__ void fused(pg8::f32x4 (&acc)[2][2][4][2], const pg8::Unit& u, int wr, int wc, int fr, int fq, PG8_LAS unsigned char* lds, int wid, int lane) const {
        using pg8::f32x4;
        PG8_LAS float* S = (PG8_LAS float*)lds;
        const int col0 = u.pn * 256 + wc * 32 + 4 * fq;
#pragma unroll
        for (int ai = 0; ai < 2; ++ai)
#pragma unroll
            for (int m = 0; m < 4; ++m) { const int r = ai * 128 + wr * 64 + m * 16 + fr; const size_t off = (size_t)(u.pm * 256 + r) * DM + col0; float ss = 0.f;
#pragma unroll
                for (int bj = 0; bj < 2; ++bj)
#pragma unroll
                    for (int n = 0; n < 2; ++n) { const f32x4 x = *(const f32x4*)(base + off + bj * 128 + n * 16); const f32x4 hv = x + acc[ai][bj][m][n];
                        *(f32x4*)(h1 + off + bj * 128 + n * 16) = hv; u32x2 w; w.x = pg8::cvt_pk_bf16(hv[0], hv[1]); w.y = pg8::cvt_pk_bf16(hv[2], hv[3]); *(u32x2*)(hb + off + bj * 128 + n * 16) = w;
                        ss += (hv[0] * hv[0] + hv[1] * hv[1]) + (hv[2] * hv[2] + hv[3] * hv[3]); }
                ss += __shfl_xor(ss, 16); ss += __shfl_xor(ss, 32);
                if (fq == 0) S[r * 4 + wc] = ss; }
        __syncthreads();
        const int tid = wid * 64 + lane;
        if (tid < 256) ssq[(size_t)(u.pm * 256 + tid) * 4 + u.pn] = (S[tid * 4] + S[tid * 4 + 1]) + (S[tid * 4 + 2] + S[tid * 4 + 3]);
        __syncthreads();
    }
};
struct EpiUp {
    static constexpr bool PERM = true, AFTER_DRAIN = false;
    bf16* O; const float* ssq;
    __device__ __forceinline__ void operator()(const pg8::f32x4 (&acc)[2][2][4][2], const pg8::Unit& u, int wr, int wc, int fr, int fq) const {
        using pg8::f32x4; using pg8::u32x4; using pg8::cvt_pk_bf16;
        const int row0 = u.pm * 256 + wr * 64 + fr, col0 = u.pn * 256 + wc * 32 + 8 * fq;
#pragma unroll
        for (int ai = 0; ai < 2; ++ai)
#pragma unroll
            for (int m = 0; m < 4; ++m) { const int row = row0 + ai * 128 + m * 16; const f32x4 s4 = *(const f32x4*)(ssq + (size_t)row * 4);
                const float rstd = 1.f / sqrtf(((s4.x + s4.y) + (s4.z + s4.w)) * (1.f / DM) + EPS); bf16* rowp = O + (size_t)row * DFF + col0;
#pragma unroll
                for (int bj = 0; bj < 2; ++bj) { f32x4 v0 = acc[ai][bj][m][0] * rstd, v1 = acc[ai][bj][m][1] * rstd;
#pragma unroll
                    for (int j = 0; j < 4; ++j) { const float a = fmaxf(v0[j], 0.f), c = fmaxf(v1[j], 0.f); v0[j] = a * a; v1[j] = c * c; }
                    u32x4 w; w.x = cvt_pk_bf16(v0[0], v0[1]); w.y = cvt_pk_bf16(v0[2], v0[3]); w.z = cvt_pk_bf16(v1[0], v1[1]); w.w = cvt_pk_bf16(v1[2], v1[3]);
                    *(u32x4*)(rowp + bj * 128) = w; } }
    }
};
struct EpiDown {
    static constexpr bool PERM = false, AFTER_DRAIN = true;
    const float* h1; float* out; float* ssq;
    __device__ __forceinline__ void fused(pg8::f32x4 (&acc)[2][2][4][2], const pg8::Unit& u, int wr, int wc, int fr, int fq, PG8_LAS unsigned char* lds, int wid, int lane) const {
        using pg8::f32x4;
        PG8_LAS float* S = (PG8_LAS float*)lds;
        const int col0 = u.pn * 256 + wc * 32 + 4 * fq;
#pragma unroll
        for (int ai = 0; ai < 2; ++ai)
#pragma unroll
            for (int m = 0; m < 4; ++m) { const int r = ai * 128 + wr * 64 + m * 16 + fr; const size_t off = (size_t)(u.pm * 256 + r) * DM + col0; float ss = 0.f;
#pragma unroll
                for (int bj = 0; bj < 2; ++bj)
#pragma unroll
                    for (int n = 0; n < 2; ++n) { const f32x4 x = *(const f32x4*)(h1 + off + bj * 128 + n * 16); const f32x4 hv = x + acc[ai][bj][m][n];
                        *(f32x4*)(out + off + bj * 128 + n * 16) = hv; ss += (hv[0] * hv[0] + hv[1] * hv[1]) + (hv[2] * hv[2] + hv[3] * hv[3]); }
                ss += __shfl_xor(ss, 16); ss += __shfl_xor(ss, 32);
                if (fq == 0) S[r * 4 + wc] = ss; }
        __syncthreads();
        const int tid = wid * 64 + lane;
        if (tid < 256) ssq[(size_t)(u.pm * 256 + tid) * 4 + u.pn] = (S[tid * 4] + S[tid * 4 + 1]) + (S[tid * 4 + 2] + S[tid * 4 + 3]);
        __syncthreads();
    }
};

__device__ __forceinline__ float row_rstd_1024(const float* p, int lane) { const GAS f32x4* xr = (const GAS f32x4*)p + lane; float s = 0.f;
#pragma unroll
    for (int j = 0; j < 4; ++j) { const f32x4 v = xr[64 * j]; s += (v.x * v.x + v.y * v.y) + (v.z * v.z + v.w * v.w); }
    return 1.f / sqrtf(wave_sum(s) * (1.f / DM) + EPS); }
__device__ __forceinline__ void sample_gemm1(Frame& F, int i) {
    LAS float* red = (LAS float*)(F.lds + RING_OFF); LAS float* tile = red + 4096;
    skinny32((const bf16*)(F.ws + WS_SMALL + SM_XS), DM, (const bf16*)(F.ws + WS_WIN), 16 * i, red, tile, F.tid);
    ((float*)(F.ws + WS_SMALL + SM_ZS))[(size_t)(F.tid >> 4) * DIN + 16 * i + (F.tid & 15)] = tile[F.tid];
    __syncthreads();
}
__device__ __forceinline__ void sample_wout(Frame& F, int i) {
    LAS float* red = (LAS float*)(F.lds + RING_OFF); LAS float* tile = red + 4096;
    skinny32((const bf16*)(F.ws + WS_SMALL + SM_MIXS), DM, (const bf16*)(F.ws + WS_WOUT), 16 * i, red, tile, F.tid);
    const int row = F.tid >> 4, col = 16 * i + (F.tid & 15); const float hv = F.xs[(size_t)row * DM + col] + tile[F.tid];
    ((float*)(F.ws + WS_SMALL + SM_H1S))[(size_t)row * DM + col] = hv; ((bf16*)(F.ws + WS_SMALL + SM_HBS))[(size_t)row * DM + col] = (bf16)f2bf(hv);
    __syncthreads();
}
__device__ __forceinline__ void sample_up(Frame& F, int i) {
    LAS float* red = (LAS float*)(F.lds + RING_OFF); LAS float* tile = red + 4096; LAS float* rs = red + 4096 + 512;
    const float* h1s = (const float*)(F.ws + WS_SMALL + SM_H1S);
    for (int rr = 0; rr < 4; ++rr) { const int row = F.wave * 4 + rr; const float x = row_rstd_1024(h1s + (size_t)row * DM, F.lane); if (F.lane == 0) rs[row] = x; }
    skinny32((const bf16*)(F.ws + WS_SMALL + SM_HBS), DM, (const bf16*)(F.ws + WS_WUP), 16 * i, red, tile, F.tid);
    const int row = F.tid >> 4, col = 16 * i + (F.tid & 15); const float a = fmaxf(tile[F.tid] * rs[row], 0.f);
    ((bf16*)(F.ws + WS_SMALL + SM_UPS))[(size_t)row * DFF + col] = (bf16)f2bf(a * a);
    __syncthreads();
}
__device__ __forceinline__ void sample_down(Frame& F, int i) {
    LAS float* red = (LAS float*)(F.lds + RING_OFF); LAS float* tile = red + 4096;
    skinny32((const bf16*)(F.ws + WS_SMALL + SM_UPS), DFF, (const bf16*)(F.ws + WS_WDOWN), 16 * i, red, tile, F.tid);
    const int row = F.tid >> 4, col = 16 * i + (F.tid & 15);
    ((float*)(F.ws + WS_SMALL + SM_H2S))[(size_t)row * DM + col] = ((const float*)(F.ws + WS_SMALL + SM_H1S))[(size_t)row * DM + col] + tile[F.tid];
    __syncthreads();
}
__device__ __forceinline__ void sample_final(Frame& F) {
    const float* h2s = (const float*)(F.ws + WS_SMALL + SM_H2S);
    for (int rr = 0; rr < 4; ++rr) { const int row = F.wave * 4 + rr; const float rstd = row_rstd_1024(h2s + (size_t)row * DM, F.lane);
#pragma unroll
        for (int j = 0; j < 4; ++j) { const int c = 4 * F.lane + 256 * j; const f32x4 v = *(const GAS f32x4*)(h2s + (size_t)row * DM + c), g = *(const GAS f32x4*)(F.gf + c); *(GAS f32x4*)(F.out + O_YS + (size_t)row * DM + c) = v * rstd * g; } }
}
__device__ __forceinline__ void final_norm(Frame& F) {
    const float* ssq = (const float*)(F.ws + WS_SSQ2); const int gw = blockIdx.x * NWAVES + F.wave, NGW = F.G * NWAVES;
    f32x4 g[4];
#pragma unroll
    for (int j = 0; j < 4; ++j) g[j] = *(const GAS f32x4*)(F.gf + 4 * F.lane + 256 * j);
    for (int m = gw; m < MP; m += NGW) { const f32x4 s4 = *(const GAS f32x4*)(ssq + (size_t)m * 4); const float rstd = 1.f / sqrtf(((s4.x + s4.y) + (s4.z + s4.w)) * (1.f / DM) + EPS);
        GAS f32x4* y = (GAS f32x4*)(F.out + O_YP + (size_t)m * DM) + F.lane;
#pragma unroll
        for (int j = 0; j < 4; ++j) y[64 * j] = y[64 * j] * rstd * g[j]; }
}

#ifndef MK_PER_PHASE
#define MK_PER_PHASE 0
#endif
constexpr int N_PHASES = 9;
struct Args { const void* in[15]; float* out; unsigned char* ws; int ph_lo, ph_hi; };
__global__ void __launch_bounds__(NWAVES * 64, 2) hymba_fwd(Args args) {
    extern __shared__ __attribute__((aligned(16))) unsigned char lds[];
    Frame F;
    F.lds = (LAS unsigned char*)lds;
    F.MISC = (volatile LAS unsigned*)(F.lds + MISC_OFF);
    F.tid = threadIdx.x; F.lane = F.tid & 63; F.wave = __builtin_amdgcn_readfirstlane(F.tid >> 6);
    F.G = gridDim.x;
    F.ws = args.ws; F.out = args.out; F.ctl = (gu32*)(args.ws + WS_CTL);
    F.xp = (const float*)args.in[0]; F.xs = (const float*)args.in[1]; F.ck = (const float*)args.in[2]; F.cv = (const float*)args.in[3]; F.st0 = (const float*)args.in[4]; F.pt = (const int*)args.in[5];
    F.g1 = (const float*)args.in[6]; F.win = (const float*)args.in[7]; F.lbl = (const float*)args.in[8]; F.hg = (const float*)args.in[9]; F.wout = (const float*)args.in[10]; F.g2 = (const float*)args.in[11];
    F.wup = (const float*)args.in[12]; F.wdown = (const float*)args.in[13]; F.gf = (const float*)args.in[14];
    for (int u = F.tid; u < (LDS_BYTES - LDSCTL_OFF) / 4; u += NWAVES * 64) ((LAS unsigned*)(F.lds + LDSCTL_OFF))[u] = 0u;
    __syncthreads();
    XcdBarrier bar; bar.bar = (unsigned*)(F.ctl + CW_BAR); bar.x = 0; bar.st = nullptr;
    if (!MK_PER_PHASE) bar = xcd_barrier_post((unsigned*)(F.ctl + CW_BAR), F.MISC + 8);
#define GRID_BAR() do { if (!MK_PER_PHASE) xcd_barrier(bar); } while (0)
    const int lo = args.ph_lo, hi = args.ph_hi; const int bx = blockIdx.x;
#ifndef ONLY_PHASE
#define ONLY_PHASE -1
#endif
#define IN(k) ((ONLY_PHASE < 0 || ONLY_PHASE == (k)) && lo <= (k) && (k) < hi)
#define BOTH(k) (IN(k) && IN((k) + 1))
    bf16* Win_t = (bf16*)(F.ws + WS_WIN); bf16* Wout_t = (bf16*)(F.ws + WS_WOUT); bf16* Wup_t = (bf16*)(F.ws + WS_WUP); bf16* Wdown_t = (bf16*)(F.ws + WS_WDOWN);
    bf16* XN = (bf16*)(F.ws + WS_XN); bf16* HB = (bf16*)(F.ws + WS_HB); bf16* UPB = (bf16*)(F.ws + WS_UP); float* H1 = (float*)(F.ws + WS_H1);

    if (IN(0)) { p0_prologue(F); if (BOTH(0)) GRID_BAR(); }
    if (IN(1)) {
        if (bx < DIN / 16) sample_gemm1(F, bx);
        pg8::Gemm g{XN, Win_t, MP, DIN, DM}; pg8::StaticOrder S; S.init(MP, DIN, F.G, bx);
        EpiZ E{(bf16*)(F.ws + WS_QA), (bf16*)(F.ws + WS_KA), (bf16*)(F.ws + WS_VA), (bf16*)(F.ws + WS_ZR), F.out + O_KP, F.out + O_VP, (float*)(F.ws + WS_KPART), (const float*)(F.ws + WS_ROPE)};
        pg8::gemm_phase<EpiZ, pg8::StaticOrder, true, true>(F.lds + RING_OFF, g, S, E);
        if (BOTH(1)) GRID_BAR();
    }
    if (IN(2)) {
        for (int u = bx; u < NB * NBLK * 4; u += F.G) { gate_unit(F, u); __syncthreads(); }
        for (int id = bx * NWAVES + F.wave; id < NB * NH * NCH; id += F.G * NWAVES) hgrn_h1(F, id);
        __syncthreads();
        for (int u = bx; u < DECB * NH; u += F.G) sample_attn_unit(F, u);
        for (int id = bx * NWAVES + F.wave; id < DECB * NH; id += F.G * NWAVES) sample_hgrn(F, id);
        if (BOTH(2)) GRID_BAR();
    }
    if (IN(3)) {
        if (bx < DM / 16) sample_wout(F, bx);
        if (bx >= 64 && bx < 64 + 128) scan_unit(F, bx - 64);
        const int NU = att_build_table(F);
        for (int u = bx; u < NU; u += F.G) attn_unit(F, u);
        if (BOTH(3)) GRID_BAR();
    }
    if (IN(4)) {
#ifndef P4_PARTS
#define P4_PARTS 7
#endif
        if (P4_PARTS & 1) for (int id = bx * NWAVES + F.wave; id < NB * NH * NCH; id += F.G * NWAVES) hgrn_h3(F, id);
        __syncthreads();
        if (P4_PARTS & 2) combine_items(F);
        if (P4_PARTS & 4) for (int u = bx; u < DFF / 16; u += F.G) sample_up(F, u);
        if (BOTH(4)) GRID_BAR();
    }
    if (IN(5)) {
        if (bx < DM / 16) sample_down(F, bx);
        pg8::Gemm g{XN, Wout_t, MP, DM, DM}; pg8::StaticOrder S; S.init(MP, DM, F.G, bx);
        EpiOut E{F.xp, H1, HB, (float*)(F.ws + WS_SSQ1)};
        pg8::gemm_phase<EpiOut, pg8::StaticOrder, false, true>(F.lds + RING_OFF, g, S, E);
        if (BOTH(5)) GRID_BAR();
    }
    if (IN(6)) {
        if (bx == 0) sample_final(F);
        pg8::Gemm g{HB, Wup_t, MP, DFF, DM}; pg8::StaticOrder S; S.init(MP, DFF, F.G, bx);
        EpiUp E{UPB, (const float*)(F.ws + WS_SSQ1)};
        pg8::gemm_phase<EpiUp, pg8::StaticOrder, true, true>(F.lds + RING_OFF, g, S, E);
        if (BOTH(6)) GRID_BAR();
    }
    if (IN(7)) {
        pg8::Gemm g{UPB, Wdown_t, MP, DM, DFF}; pg8::StaticOrder S; S.init(MP, DM, F.G, bx);
        EpiDown E{H1, F.out + O_YP, (float*)(F.ws + WS_SSQ2)};
        pg8::gemm_phase<EpiDown, pg8::StaticOrder, false, true>(F.lds + RING_OFF, g, S, E);
        if (BOTH(7)) GRID_BAR();
    }
    if (IN(8)) final_norm(F);
#undef IN
#undef BOTH
}

#ifdef PROBE_DUMP
__global__ void probe_dump(const unsigned short* src, float* dst, size_t n, int c0, int c1) {
    for (size_t i = (size_t)blockIdx.x * blockDim.x + threadIdx.x; i < n; i += (size_t)gridDim.x * blockDim.x) { const int c = (int)(i & 1023); dst[i] = (c >= c0 && c < c1) ? __builtin_bit_cast(float, (unsigned)src[i] << 16) : 0.f; }
}
#endif
extern "C" void kernel_launch(void* const* d_in, const int* in_sizes, int n_in, void* d_out, int out_size, void* d_ws, size_t ws_size, hipStream_t stream) {
    static int grid = 0;
    if (grid == 0) {
        if (n_in != 15 || (size_t)out_size != O_END || ws_size < WS_END) { fprintf(stderr, "kernel_launch: unexpected problem (n_in %d, out %d, ws %zu); nothing launched\n", n_in, out_size, ws_size); grid = -1; return; }
        int dev = 0, cus = 0;
        if (hipGetDevice(&dev) != hipSuccess || hipDeviceGetAttribute(&cus, hipDeviceAttributeMultiprocessorCount, dev) != hipSuccess) { grid = -1; return; }
        if (hipFuncSetAttribute((const void*)hymba_fwd, hipFuncAttributeMaxDynamicSharedMemorySize, LDS_BYTES) != hipSuccess) { fprintf(stderr, "kernel_launch: hipFuncSetAttribute failed\n"); grid = -1; return; }
        int per_cu = 0;
        if (hipOccupancyMaxActiveBlocksPerMultiprocessor(&per_cu, (const void*)hymba_fwd, NWAVES * 64, LDS_BYTES) != hipSuccess || per_cu < 1) fprintf(stderr, "kernel_launch: occupancy query reports %d\n", per_cu);
        (void)hipGetLastError();
        grid = cus;
        if (grid != 256) { fprintf(stderr, "kernel_launch: built for a 256-CU device, found %d CUs; nothing launched\n", cus); grid = -1; return; }
    }
    if (grid < 0) return;
    if (hipMemsetAsync((char*)d_ws + WS_CTL, 0, CTL_ZERO_BYTES, stream) != hipSuccess) return;
    Args a{};
    for (int i = 0; i < 15; ++i) a.in[i] = d_in[i];
    a.out = (float*)d_out; a.ws = (unsigned char*)d_ws;
#ifndef RUN_PHASES
#define RUN_PHASES N_PHASES
#endif
#if MK_PER_PHASE
    if (RUN_PHASES < N_PHASES) (void)hipMemsetAsync(d_out, 0, O_END * sizeof(float), stream);
    for (int p = 0; p < RUN_PHASES; ++p) { a.ph_lo = p; a.ph_hi = p + 1; hipLaunchKernelGGL(hymba_fwd, dim3(grid), dim3(NWAVES * 64), LDS_BYTES, stream, a); }
#ifdef PROBE_DUMP
    hipLaunchKernelGGL(probe_dump, dim3(2048), dim3(256), 0, stream, (const unsigned short*)((unsigned char*)d_ws + PROBE_SRC), (float*)d_out + O_YP, (size_t)MP * DM, PROBE_C0, PROBE_C1);
#endif
#else
    a.ph_lo = 0; a.ph_hi = N_PHASES;
    hipLaunchKernelGGL(hymba_fwd, dim3(grid), dim3(NWAVES * 64), LDS_BYTES, stream, a);
#endif
    const hipError_t le = hipPeekAtLastError();
    if (le != hipSuccess) fprintf(stderr, "kernel_launch: launch failed: %s\n", hipGetErrorName(le));
}
```

```cpp
#include <hip/hip_runtime.h>
#include <cstdio>
#include <cstdint>
namespace pg8 {
#define PG8_LAS __attribute__((address_space(3)))
typedef unsigned short bf16_t;
typedef short bf16x8 __attribute__((ext_vector_type(8)));
typedef float f32x4 __attribute__((ext_vector_type(4)));
typedef unsigned u32x4 __attribute__((ext_vector_type(4)));
constexpr int BM = 256, BK = 64, HALF = 128, HTB = HALF * BK * 2  , STAGE_BYTES = 8 * HTB, NXCD = 8, WGM = 8;

__host__ __device__ __forceinline__ int lds_byte(int r, int c) { const int st = (r >> 4) * 2 + (c >> 5), rr = r & 15, cc = c & 31, ob = rr * 64 + cc * 2; return st * 1024 + (ob ^ (((ob >> 9) & 1) << 5)); }
__host__ __device__ __forceinline__ void stage_rc(int b, int& R, int& C) { const int st = b / 1024, sb = b % 1024, swz = sb ^ (((sb >> 9) & 1) << 5); R = (st >> 1) * 16 + swz / 64; C = (st & 1) * 32 + (swz % 64) / 2; }
__host__ __device__ __forceinline__ int perm32(int rho) { const int n = rho >> 4, i = rho & 15; return 8 * (i >> 2) + 4 * n + (i & 3); }

struct Unit { int pm, pn; };
struct Gemm { const bf16_t* A; const bf16_t* Bt; int M, N, K; };

struct StaticOrder {
    int nM, nN, nwg, G, c;
    __host__ __device__ void init(int M, int N, int G_, int c_) { nM = M / BM; nN = N / BM; nwg = nM * nN; G = G_; c = c_; }
    __host__ __device__ bool next(int i, Unit& u) const {
        const long L = (long)i * G + c; if (L >= nwg) return false;
        int wgid = (int)L; { const int q = nwg / NXCD, r = nwg % NXCD, xcd = wgid % NXCD, off = wgid / NXCD; wgid = (xcd < r ? xcd * (q + 1) : r * (q + 1) + (xcd - r) * q) + off; }
        const int nig = WGM * nN, gid = wgid / nig, fm = gid * WGM, gsz = (nM - fm) < WGM ? (nM - fm) : WGM;
        u.pm = fm + ((wgid % nig) % gsz); u.pn = (wgid % nig) / gsz; return true;
    }
    __device__ __forceinline__ void a_ready(const Unit&) const {}
    __device__ __forceinline__ void done(const Unit&) const {}
};

__device__ __forceinline__ unsigned cvt_pk_bf16(float lo, float hi) { unsigned r; asm volatile("v_cvt_pk_bf16_f32 %0, %1, %2" : "=v"(r) : "v"(lo), "v"(hi)); return r; }
typedef float f32x2 __attribute__((ext_vector_type(2)));
template <class Epi, class Sched, bool ALIGN_EPI = false, bool SP2 = false>
__device__ __forceinline__ void gemm_phase(PG8_LAS unsigned char* lds, const Gemm g, const Sched& S, const Epi& E) {
    const int tid = threadIdx.x, wid = __builtin_amdgcn_readfirstlane(tid >> 6), lane = tid & 63, wr = wid >> 2, wc = wid & 3, fr = lane & 15, fq = lane >> 4;
    const int K = g.K, nt = K / BK;
    unsigned voffA[2], voffB[2];
#pragma unroll
    for (int i = 0; i < 2; ++i) { int R, C; stage_rc(tid * 16 + i * 8192, R, C); const int Rb = Epi::PERM ? ((R & ~31) + perm32(R & 31)) : R;
        voffA[i] = (unsigned)(R * K + C) * 2u; voffB[i] = (unsigned)(Rb * K + C) * 2u; }
    const size_t kstep = (size_t)(BK * 2);
    const size_t hstep = (size_t)HALF * K * 2;
    const size_t tstep = 2 * hstep;
    const unsigned ldsw = (unsigned)wid * 1024u;
    const int aoff = lds_byte(wr * 64 + fr, fq * 8), boff = lds_byte(wc * 32 + fr, fq * 8);
#define PG8_SA(b, h) (((b) * 2 + (h)) * HTB)
#define PG8_SB(b, h) ((4 + (b) * 2 + (h)) * HTB)
#define PG8_STAGE(bufoff, gbase, voff) do { _Pragma("unroll") for (int _i = 0; _i < 2; ++_i) \
        __builtin_amdgcn_global_load_lds((const unsigned*)((const char*)(gbase) + (voff)[_i]), (PG8_LAS unsigned*)(lds + (bufoff) + ldsw + _i * 8192), 16, 0, 0); } while (0)
#define PG8_LDA(dst, b, h) do { _Pragma("unroll") for (int m = 0; m < 4; ++m) _Pragma("unroll") for (int k = 0; k < 2; ++k) dst[m][k] = *(const PG8_LAS bf16x8*)(lds + PG8_SA(b, h) + aoff + m * 2048 + k * 1024); } while (0)
#define PG8_LDB(dst, b, h) do { _Pragma("unroll") for (int n = 0; n < 2; ++n) _Pragma("unroll") for (int k = 0; k < 2; ++k) dst[n][k] = *(const PG8_LAS bf16x8*)(lds + PG8_SB(b, h) + boff + n * 2048 + k * 1024); } while (0)
#define PG8_MMA(ai, bj, At, Bt) do { __builtin_amdgcn_s_setprio(1); _Pragma("unroll") for (int m = 0; m < 4; ++m) _Pragma("unroll") for (int n = 0; n < 2; ++n) _Pragma("unroll") for (int k = 0; k < 2; ++k) \
        acc[ai][bj][m][n] = __builtin_amdgcn_mfma_f32_16x16x32_bf16(Bt[n][k], At[m][k], acc[ai][bj][m][n], 0, 0, 0); __builtin_amdgcn_s_setprio(0); } while (0)
#define PG8_WAIT_V(n) asm volatile("s_waitcnt vmcnt(" #n ")" ::: "memory")
#define PG8_WAIT_L(n) asm volatile("s_waitcnt lgkmcnt(" #n ")" ::: "memory")
#define PG8_BAR __builtin_amdgcn_s_barrier()
#define PG8_SCHED __builtin_amdgcn_sched_barrier(0)
    Unit cur, nxt; int ui = 0;
    if (!S.next(0, cur)) return;
    f32x4 acc[2][2][4][2];
#pragma unroll
    for (int a = 0; a < 2; ++a)
#pragma unroll
        for (int b = 0; b < 2; ++b)
#pragma unroll
            for (int m = 0; m < 4; ++m)
#pragma unroll
                for (int n = 0; n < 2; ++n) acc[a][b][m][n] = (f32x4){0.f, 0.f, 0.f, 0.f};
    bf16x8 At[4][2], B0[2][2], B1[2][2];
    const char* cA = (const char*)g.A + (size_t)cur.pm * tstep; const char* cB = (const char*)g.Bt + (size_t)cur.pn * tstep;
    S.a_ready(cur);
    if constexpr (SP2) {
        PG8_STAGE(PG8_SB(0, 0), cB, voffB); PG8_STAGE(PG8_SB(0, 1), cB + hstep, voffB); PG8_STAGE(PG8_SA(0, 0), cA, voffA); PG8_STAGE(PG8_SA(0, 1), cA + hstep, voffA);
        if (wr == 1) PG8_BAR;
        PG8_WAIT_V(2); PG8_BAR;
        PG8_STAGE(PG8_SB(1, 0), cB + kstep, voffB); PG8_STAGE(PG8_SA(1, 0), cA + kstep, voffA); PG8_STAGE(PG8_SB(1, 1), cB + hstep + kstep, voffB);
        PG8_WAIT_V(6); PG8_BAR;
    } else {
        PG8_STAGE(PG8_SB(0, 0), cB, voffB); PG8_STAGE(PG8_SA(0, 0), cA, voffA); PG8_STAGE(PG8_SB(0, 1), cB + hstep, voffB); PG8_STAGE(PG8_SA(0, 1), cA + hstep, voffA);
        if (wr == 1) PG8_BAR;
        PG8_WAIT_V(4); PG8_BAR;
        PG8_STAGE(PG8_SB(1, 0), cB + kstep, voffB); PG8_STAGE(PG8_SA(1, 0), cA + kstep, voffA); PG8_STAGE(PG8_SB(1, 1), cB + hstep + kstep, voffB);
        PG8_WAIT_V(6); PG8_BAR;
    }
    for (;;) {
        const bool has_next = S.next(ui + 1, nxt);
        const char* nA = has_next ? (const char*)g.A + (size_t)nxt.pm * tstep : cA; const char* nB = has_next ? (const char*)g.Bt + (size_t)nxt.pn * tstep : cB;
        for (int t = 0; t < nt; t += 2) {
            const bool last = (t == nt - 2);
            const char* a1 = cA + (size_t)(t + 1) * kstep;
            const char* a2 = last ? nA : cA + (size_t)(t + 2) * kstep; const char* b2 = last ? nB : cB + (size_t)(t + 2) * kstep;
            const char* a3 = a2 + kstep; const char* b3 = b2 + kstep;
            if (last && has_next) S.a_ready(nxt);
            if constexpr (SP2) {
            PG8_LDB(B0, 0, 0); PG8_LDB(B1, 0, 1); PG8_SCHED; PG8_LDA(At, 0, 0); PG8_STAGE(PG8_SA(1, 1), a1 + hstep, voffA);
            PG8_WAIT_V(8); PG8_WAIT_L(0); PG8_BAR; PG8_MMA(0, 0, At, B0); PG8_MMA(0, 1, At, B1); PG8_BAR; PG8_SCHED;
            PG8_LDA(At, 0, 1); PG8_STAGE(PG8_SB(0, 0), b2, voffB); PG8_STAGE(PG8_SB(0, 1), b2 + hstep, voffB); PG8_STAGE(PG8_SA(0, 0), a2, voffA);
            PG8_WAIT_V(8); PG8_WAIT_L(0); PG8_BAR; PG8_MMA(1, 0, At, B0); PG8_MMA(1, 1, At, B1); PG8_BAR; PG8_SCHED;
            PG8_LDB(B0, 1, 0); PG8_LDB(B1, 1, 1); PG8_SCHED; PG8_LDA(At, 1, 0); PG8_STAGE(PG8_SA(0, 1), a2 + hstep, voffA);
            PG8_WAIT_V(8); PG8_WAIT_L(0); PG8_BAR; PG8_MMA(0, 0, At, B0); PG8_MMA(0, 1, At, B1); PG8_BAR; PG8_SCHED;
            PG8_LDA(At, 1, 1); PG8_STAGE(PG8_SB(1, 0), b3, voffB); PG8_STAGE(PG8_SB(1, 1), b3 + hstep, voffB); PG8_STAGE(PG8_SA(1, 0), a3, voffA);
            PG8_WAIT_V(8); PG8_WAIT_L(0); PG8_BAR; PG8_MMA(1, 0, At, B0); PG8_MMA(1, 1, At, B1); PG8_BAR; PG8_SCHED;
            } else {
            PG8_LDB(B0, 0, 0); PG8_SCHED; PG8_LDA(At, 0, 0); PG8_STAGE(PG8_SA(1, 1), a1 + hstep, voffA);
            PG8_WAIT_L(8); PG8_BAR; PG8_WAIT_L(0); PG8_MMA(0, 0, At, B0); PG8_BAR; PG8_SCHED;
            PG8_LDB(B1, 0, 1); PG8_STAGE(PG8_SB(0, 0), b2, voffB);
            PG8_BAR; PG8_WAIT_L(0); PG8_MMA(0, 1, At, B1); PG8_BAR;
            PG8_LDA(At, 0, 1); PG8_STAGE(PG8_SA(0, 0), a2, voffA);
            PG8_BAR; PG8_WAIT_L(0); PG8_MMA(1, 0, At, B0); PG8_BAR; PG8_SCHED;
            PG8_STAGE(PG8_SB(0, 1), b2 + hstep, voffB);
            PG8_WAIT_V(6); PG8_BAR; PG8_MMA(1, 1, At, B1); PG8_BAR;
            PG8_LDB(B0, 1, 0); PG8_SCHED; PG8_LDA(At, 1, 0); PG8_STAGE(PG8_SA(0, 1), a2 + hstep, voffA);
            PG8_WAIT_L(8); PG8_BAR; PG8_WAIT_L(0); PG8_MMA(0, 0, At, B0); PG8_BAR; PG8_SCHED;
            PG8_LDB(B1, 1, 1); PG8_STAGE(PG8_SB(1, 0), b3, voffB);
            PG8_BAR; PG8_WAIT_L(0); PG8_MMA(0, 1, At, B1); PG8_BAR;
            PG8_LDA(At, 1, 1); PG8_STAGE(PG8_SA(1, 0), a3, voffA);
            PG8_BAR; PG8_WAIT_L(0); PG8_MMA(1, 0, At, B0); PG8_BAR; PG8_SCHED;
            PG8_STAGE(PG8_SB(1, 1), b3 + hstep, voffB);
            PG8_WAIT_V(6); PG8_BAR; PG8_MMA(1, 1, At, B1); PG8_BAR;
            }
        }
        if constexpr (ALIGN_EPI) { if (wr == 0) PG8_BAR; }
        if constexpr (!Epi::AFTER_DRAIN) { E(acc, cur, wr, wc, fr, fq); S.done(cur); }
        if (!has_next) break;
#pragma unroll
        for (int a = 0; a < 2; ++a)
#pragma unroll
            for (int b = 0; b < 2; ++b)
#pragma unroll
                for (int m = 0; m < 4; ++m)
#pragma unroll
                    for (int n = 0; n < 2; ++n) acc[a][b][m][n] = (f32x4){0.f, 0.f, 0.f, 0.f};
        cur = nxt; cA = nA; cB = nB; ++ui;
        if constexpr (ALIGN_EPI) { if (wr == 1) PG8_BAR; }
    }
    PG8_WAIT_V(0);
    if constexpr (!ALIGN_EPI) { if (wr == 0) PG8_BAR; }
    PG8_BAR;
    if constexpr (Epi::AFTER_DRAIN) { E.fused(acc, cur, wr, wc, fr, fq, lds, wid, lane); S.done(cur); }
#undef PG8_SA
#undef PG8_SB
#undef PG8_STAGE
#undef PG8_LDA
#undef PG8_LDB
#undef PG8_MMA
#undef PG8_WAIT_V
#undef PG8_WAIT_L
#undef PG8_BAR
#undef PG8_SCHED
}
}
#define GAS __attribute__((address_space(1)))
#define LAS __attribute__((address_space(3)))
typedef unsigned short bf16;
typedef unsigned v4u __attribute__((ext_vector_type(4)));
typedef float f32x4 __attribute__((ext_vector_type(4)));
typedef short bf16x8 __attribute__((ext_vector_type(8)));
typedef GAS unsigned gu32;
typedef GAS unsigned long long gu64;
#define RLX_AGENT __ATOMIC_RELAXED, __HIP_MEMORY_SCOPE_AGENT
#define LDS_WAIT() asm volatile("s_waitcnt lgkmcnt(0)" ::: "memory")
#define VM_WAIT() asm volatile("s_waitcnt vmcnt(0)" ::: "memory")
__device__ __forceinline__ unsigned long long rt() { return __builtin_amdgcn_s_memrealtime(); }
__device__ __forceinline__ unsigned f2bf(float f) { unsigned u = __builtin_bit_cast(unsigned, f); return (u + 0x7fffu + ((u >> 16) & 1u)) >> 16; }
__device__ __forceinline__ unsigned pk2(float lo, float hi) { return f2bf(lo) | (f2bf(hi) << 16); }

#define XB_TMO      128
#define XB_XCNT(j)  (256  + 64 * (j))
#define XB_XSUB(j)  (1280 + 64 * (j))
#define XB_XGEN(j)  (2304 + 64 * (j))
#define XB_TOP      3328
#define XB_TOPGEN   3392
#define XCD_BAR_WORDS 3456
#define XB_SPIN_CAP (1u << 18)

__device__ __forceinline__ unsigned xb_ld(unsigned* p)              { return __hip_atomic_load(p, __ATOMIC_RELAXED, __HIP_MEMORY_SCOPE_AGENT); }
__device__ __forceinline__ unsigned xb_add(unsigned* p, unsigned v) { return __hip_atomic_fetch_add(p, v, __ATOMIC_RELAXED, __HIP_MEMORY_SCOPE_AGENT); }
__device__ __forceinline__ unsigned xb_xcc_id() { return (unsigned)__builtin_amdgcn_s_getreg((3 << 11) | 20) & 0xFu; }
#define XB_SPIN(cond, bar) do { unsigned _sp = 0; while (cond) { __builtin_amdgcn_s_sleep(1); \
    if ((++_sp & 255u) == 0u) { if (xb_ld(&(bar)[XB_TMO])) break; if (_sp > XB_SPIN_CAP) { atomicAdd(&(bar)[XB_TMO], 1u); break; } } } } while (0)

struct XcdBarrier {
    unsigned* bar; unsigned x;
    volatile LAS unsigned* st;
};

__device__ __forceinline__ XcdBarrier xcd_barrier_post(unsigned* bar, volatile LAS unsigned* st) {
    XcdBarrier b; b.bar = bar; b.x = xb_xcc_id(); b.st = st;
    if (threadIdx.x == 0) (void)xb_add(&bar[XB_XCNT(b.x)], 1u);
    return b;
}
__device__ __forceinline__ void xcd_barrier_complete(unsigned* bar, unsigned x, unsigned& nloc, unsigned& nx) {
    const unsigned G = gridDim.x * gridDim.y * gridDim.z;
    unsigned sum, cnt, mine, sp = 0u;
    for (;;) {
        sum = 0u; cnt = 0u; mine = 0u;
#pragma unroll
        for (unsigned j = 0; j < 16; ++j) { const unsigned c = xb_ld(&bar[XB_XCNT(j)]); sum += c; cnt += (c > 0u) ? 1u : 0u; mine = (j == x) ? c : mine; }
        if (sum == G) break;
        __builtin_amdgcn_s_sleep(1);
        if ((++sp & 255u) == 0u) { if (xb_ld(&bar[XB_TMO])) break; if (sp > XB_SPIN_CAP) { atomicAdd(&bar[XB_TMO], 1u); break; } }
    }
    nloc = mine > 0u ? mine : 1u; nx = cnt > 0u ? cnt : 1u;
}

__device__ __forceinline__ void xcd_barrier(const XcdBarrier& b) {
    asm volatile("s_waitcnt vmcnt(0)" ::: "memory");
    __syncthreads();
    if (threadIdx.x == 0) {
        unsigned* bar = b.bar;
        __builtin_amdgcn_s_waitcnt(0);
        unsigned nloc = b.st[0], nx = b.st[1];
        if (nloc == 0u) { xcd_barrier_complete(bar, b.x, nloc, nx); b.st[0] = nloc; b.st[1] = nx; }
        const unsigned old = xb_add(&bar[XB_XSUB(b.x)], 1u);
        const unsigned gen = old / nloc;
        if (old + 1u == (gen + 1u) * nloc) {
            __builtin_amdgcn_fence(__ATOMIC_RELEASE, "agent");
            asm volatile("s_waitcnt vmcnt(0)" ::: "memory");
            const unsigned og = xb_add(&bar[XB_TOP], 1u);
            const unsigned tg = og / nx;
            if (og + 1u == (tg + 1u) * nx) xb_add(&bar[XB_TOPGEN], 1u);
            else XB_SPIN(xb_ld(&bar[XB_TOPGEN]) == tg, bar);
            __builtin_amdgcn_fence(__ATOMIC_ACQUIRE, "agent");
            xb_add(&bar[XB_XGEN(b.x)], 1u);
            asm volatile("s_waitcnt vmcnt(0)" ::: "memory");
        } else {
            XB_SPIN(xb_ld(&bar[XB_XGEN(b.x)]) == gen, bar);
            __builtin_amdgcn_fence(__ATOMIC_ACQUIRE, "agent");
            asm volatile("s_waitcnt vmcnt(0)" ::: "memory");
        }
    }
    __syncthreads();
}

constexpr int NWAVES = 8;
constexpr int DM = 1024, NB = 2, SEQ = 8192, MP = NB * SEQ, DECB = 32, PAST = 8192, PAGE = 128, NPAGES = PAST / PAGE;
constexpr int HD = 64, NH = 8, DATT = 512, DIN = 3584, DFF = 4096, BLK = 256, NBLK = SEQ / BLK, CH = 64, NCH = SEQ / CH;
constexpr float EPS = 1e-6f;
constexpr float QSCALE = 0.125f * 1.4426950408889634f;
constexpr size_t O_YP = 0, O_YS = O_YP + (size_t)MP * DM, O_KP = O_YS + (size_t)DECB * DM, O_VP = O_KP + (size_t)MP * DATT, O_SP = O_VP + (size_t)MP * DATT,
                 O_KS = O_SP + (size_t)NB * NH * 64 * 64, O_VS = O_KS + (size_t)DECB * DATT, O_SS = O_VS + (size_t)DECB * DATT, O_END = O_SS + (size_t)DECB * NH * 64 * 64;
static_assert(O_END == 34734080, "d_out map");
constexpr size_t MiB = 1u << 20;
constexpr size_t WS_CTL = 0, CTL_ZERO_BYTES = 1 * MiB;
constexpr size_t WS_WIN = 2 * MiB, WS_WOUT = 9 * MiB, WS_WUP = 11 * MiB, WS_WDOWN = 19 * MiB;
constexpr size_t WS_ROPE = 27 * MiB;
constexpr size_t WS_SMALL = 28 * MiB;
constexpr size_t SM_XS = 0, SM_ZS = 65536, SM_MIXS = SM_ZS + 458752, SM_H1S = SM_MIXS + 65536, SM_HBS = SM_H1S + 131072, SM_UPS = SM_HBS + 65536, SM_H2S = SM_UPS + 262144, SM_LB = SM_H2S + 131072, SM_END = SM_LB + 2048;
static_assert(SM_END <= 2 * MiB, "small map");
constexpr size_t WS_KSUMS = 30 * MiB;
constexpr size_t WS_KPART = 34 * MiB;
constexpr size_t WS_SSQ1 = 35 * MiB, WS_SSQ2 = WS_SSQ1 + 512 * 1024;
constexpr size_t WS_LIST = 36 * MiB;
constexpr size_t WS_ML = 52 * MiB;
constexpr size_t WS_XN = 64 * MiB;
constexpr size_t WS_HB = 96 * MiB;
constexpr size_t WS_QA = 128 * MiB, WS_KA = 144 * MiB, WS_VA = 160 * MiB;
constexpr size_t WS_ZR = 176 * MiB;
constexpr size_t WS_OPART = 240 * MiB;
constexpr size_t WS_UP = 128 * MiB;
constexpr size_t WS_UT = 304 * MiB;
constexpr size_t WS_ST = 336 * MiB;
constexpr size_t WS_DC = 352 * MiB;
constexpr size_t WS_H1 = 354 * MiB;
constexpr size_t WS_END = 418 * MiB;
constexpr int CW_TMO = 0, CW_CODE = 1, CW_BAR = 4096, CW_TOT = 16384;
constexpr int RING_OFF = 0, RING_BYTES = 131072;
constexpr int LDSCTL_OFF = RING_BYTES, MISC_OFF = LDSCTL_OFF + 320;
constexpr int LDS_BYTES = 147456;

typedef float f32x16 __attribute__((ext_vector_type(16)));
typedef short s16x4 __attribute__((ext_vector_type(4)));
typedef unsigned u32x2 __attribute__((ext_vector_type(2)));
__device__ __forceinline__ float wave_sum(float v) {
#pragma unroll
    for (int o = 1; o < 64; o <<= 1) v += __shfl_xor(v, o);
    return v;
}
__device__ __forceinline__ float bf2f(unsigned short b) { return __builtin_bit_cast(float, (unsigned)b << 16); }
__device__ __forceinline__ float bflo(unsigned w) { return __builtin_bit_cast(float, w << 16); }
__device__ __forceinline__ float bfhi(unsigned w) { return __builtin_bit_cast(float, w & 0xffff0000u); }
#define MFMA16(a, b, c) __builtin_amdgcn_mfma_f32_16x16x32_bf16((a), (b), (c), 0, 0, 0)
#define MFMA32(a, b, c) __builtin_amdgcn_mfma_f32_32x32x16_bf16((a), (b), (c), 0, 0, 0)

struct Frame {
    LAS unsigned char* lds;
    volatile LAS unsigned* MISC;
    gu32* ctl;
    int tid, lane, wave, G;
    unsigned char* ws; float* out;
    const float *xp, *xs, *ck, *cv, *st0, *g1, *win, *lbl, *hg, *wout, *g2, *wup, *wdown, *gf; const int* pt;
};

__device__ __forceinline__ void p0_transpose_item(const float* W, int K, int N, bf16* WT, const float* gain, LAS float* scr, int item, int lane) {
    const int nblk = N / 32, kb = item / nblk, nb = item % nblk, k0 = 64 * kb, n0 = 32 * nb;
#pragma unroll 8
    for (int i = 0; i < 32; ++i) { const int kk = 2 * i + (lane >> 5); const float g = gain ? gain[k0 + kk] : 1.f; scr[kk * 33 + (lane & 31)] = W[(size_t)(k0 + kk) * N + n0 + (lane & 31)] * g; }
    LDS_WAIT(); asm volatile("" ::: "memory");
    const int c = lane & 7;
#pragma unroll
    for (int j = 0; j < 4; ++j) { const int n = (lane >> 3) + 8 * j; const LAS float* s = scr + (8 * c) * 33 + n;
        v4u o; o.x = pk2(s[0 * 33], s[1 * 33]); o.y = pk2(s[2 * 33], s[3 * 33]); o.z = pk2(s[4 * 33], s[5 * 33]); o.w = pk2(s[6 * 33], s[7 * 33]);
        *(GAS v4u*)(WT + (size_t)(n0 + n) * K + k0 + 8 * c) = o; }
    LDS_WAIT(); asm volatile("" ::: "memory");
}
__device__ __forceinline__ void rms_row_to_bf16(int lane, const float* xrow, bf16* orow) {
    const GAS f32x4* xr = (const GAS f32x4*)xrow + lane;
    f32x4 v[4]; float s = 0.f;
#pragma unroll
    for (int j = 0; j < 4; ++j) { v[j] = xr[64 * j]; s += (v[j].x * v[j].x + v[j].y * v[j].y) + (v[j].z * v[j].z + v[j].w * v[j].w); }
    const float rstd = 1.f / sqrtf(wave_sum(s) * (1.f / DM) + EPS);
    GAS unsigned long long* o8 = (GAS unsigned long long*)orow + lane;
#pragma unroll
    for (int j = 0; j < 4; ++j) o8[64 * j] = (unsigned long long)pk2(v[j].x * rstd, v[j].y * rstd) | ((unsigned long long)pk2(v[j].z * rstd, v[j].w * rstd) << 32);
}
__device__ __forceinline__ void sincos_d(double a, double& s, double& c) {
    const double q = rint(a * 0.6366197723675814);
    double r = fma(-q, 1.5707963267948966, a); r = fma(-q, 6.123233995736766e-17, r);
    const int qi = (int)q & 3; const double r2 = r * r;
    const double sp = r * (1.0 + r2 * (-1.0 / 6 + r2 * (1.0 / 120 + r2 * (-1.0 / 5040 + r2 * (1.0 / 362880 + r2 * (-1.0 / 39916800 + r2 * (1.0 / 6227020800.0)))))));
    const double cp = 1.0 + r2 * (-0.5 + r2 * (1.0 / 24 + r2 * (-1.0 / 720 + r2 * (1.0 / 40320 + r2 * (-1.0 / 3628800 + r2 * (1.0 / 479001600.0 + r2 * (-1.0 / 87178291200.0)))))));
    s = (qi == 0) ? sp : (qi == 1) ? cp : (qi == 2) ? -sp : -cp;
    c = (qi == 0) ? cp : (qi == 1) ? -sp : (qi == 2) ? -cp : sp;
}
__device__ __forceinline__ double rope_inv(int i) {
    return i == 0 ? 1.0 : i == 1 ? 0.1939227447486858 : i == 2 ? 0.03760603093086394 : i == 3 ? 0.007292664737217109 : i == 4 ? 0.0014142135623730955 : i == 5 ? 0.00027424817567620724 : i == 6 ? 5.318295896944988e-05 : 1.0313385377212461e-05;
}

constexpr int KSUM_ITEMS = DECB * NPAGES, KSUM_P1_PER_WG = 4, KSUM_P1 = 128 * KSUM_P1_PER_WG, KSUM_P0 = KSUM_ITEMS - KSUM_P1;
__device__ __forceinline__ void ksum_item(Frame& F, int it) {
    LAS float* red = (LAS float*)(F.lds + RING_OFF);
    const int page = F.pt[it];
    const GAS f32x4* src = (const GAS f32x4*)(F.ck + (size_t)page * PAGE * DATT) + (size_t)(F.wave * 16) * 128 + F.lane;
    f32x4 a0 = {0.f, 0.f, 0.f, 0.f}, a1 = a0;
#pragma unroll
    for (int r = 0; r < 16; ++r) { a0 += src[r * 128]; a1 += src[r * 128 + 64]; }
    *(LAS f32x4*)(red + F.wave * 512 + 4 * F.lane) = a0; *(LAS f32x4*)(red + F.wave * 512 + 256 + 4 * F.lane) = a1;
    __syncthreads();
    float s = 0.f;
#pragma unroll
    for (int w = 0; w < 8; ++w) s += red[w * 512 + F.tid];
    ((float*)(F.ws + WS_KSUMS))[(size_t)it * 512 + F.tid] = s;
    __syncthreads();
}
__device__ __forceinline__ void p0_prologue(Frame& F) {
    LAS float* scr = (LAS float*)(F.lds + RING_OFF + F.wave * 16384);
    const int gw = blockIdx.x * NWAVES + F.wave, NGW = F.G * NWAVES;
    bf16* Win_t = (bf16*)(F.ws + WS_WIN); bf16* Wout_t = (bf16*)(F.ws + WS_WOUT); bf16* Wup_t = (bf16*)(F.ws + WS_WUP); bf16* Wdown_t = (bf16*)(F.ws + WS_WDOWN);
    constexpr int I_IN = (DM / 64) * (DIN / 32), I_OUT = (DM / 64) * (DM / 32), I_UP = (DM / 64) * (DFF / 32), I_DN = (DFF / 64) * (DM / 32);
    constexpr int NITEMS = I_IN + I_OUT + I_UP + I_DN;
    for (int it = gw; it < NITEMS; it += NGW) {
        int r = it;
        if (r < I_IN) { p0_transpose_item(F.win, DM, DIN, Win_t, F.g1, scr, r, F.lane); continue; } r -= I_IN;
        if (r < I_OUT) { p0_transpose_item(F.wout, DM, DM, Wout_t, nullptr, scr, r, F.lane); continue; } r -= I_OUT;
        if (r < I_UP) { p0_transpose_item(F.wup, DM, DFF, Wup_t, F.g2, scr, r, F.lane); continue; } r -= I_UP;
        p0_transpose_item(F.wdown, DFF, DM, Wdown_t, nullptr, scr, r, F.lane);
    }
    bf16* XN = (bf16*)(F.ws + WS_XN); bf16* XS = (bf16*)(F.ws + WS_SMALL + SM_XS);
    for (int m = gw; m < MP + DECB; m += NGW) { if (m < MP) rms_row_to_bf16(F.lane, F.xp + (size_t)m * DM, XN + (size_t)m * DM); else rms_row_to_bf16(F.lane, F.xs + (size_t)(m - MP) * DM, XS + (size_t)(m - MP) * DM); }
    float* rope = (float*)(F.ws + WS_ROPE);
    for (int e = blockIdx.x * (NWAVES * 64) + F.tid; e < (SEQ + 1) * 8; e += F.G * NWAVES * 64) { const int pos = e >> 3, i = e & 7; double s, c; sincos_d((double)pos * rope_inv(i), s, c); rope[pos * 16 + i] = (float)c; rope[pos * 16 + 8 + i] = (float)s; }
    float* LB = (float*)(F.ws + WS_SMALL + SM_LB);
    if (blockIdx.x == 0) { const int i = F.tid; const float l0 = F.lbl[i], l1 = F.lbl[512 + i]; LB[i] = 1.f / (1.f + expf(l1 - l0)); }
    __syncthreads();
    for (int it = blockIdx.x; it < KSUM_P0; it += F.G) ksum_item(F, it);
}

__device__ __forceinline__ void skinny32(const bf16* A, int K, const bf16* Wt, int n0, LAS float* red  , LAS float* out  , int tid) {
    const int w = tid >> 6, lane = tid & 63, r = lane & 15, q = lane >> 4, kper = K / 8, k0 = w * kper;
    pg8::f32x4 acc0 = {0.f, 0.f, 0.f, 0.f}, acc1 = acc0;
    const bf16* wp = Wt + (size_t)(n0 + r) * K + k0 + 8 * q; const bf16* ap0 = A + (size_t)r * K + k0 + 8 * q; const bf16* ap1 = ap0 + (size_t)16 * K;
    for (int kk = 0; kk < kper; kk += 32) {
        const bf16x8 b = *(const GAS bf16x8*)(wp + kk), a0 = *(const GAS bf16x8*)(ap0 + kk), a1 = *(const GAS bf16x8*)(ap1 + kk);
        acc0 = MFMA16(a0, b, acc0); acc1 = MFMA16(a1, b, acc1);
    }
#pragma unroll
    for (int j = 0; j < 4; ++j) { red[w * 512 + (4 * q + j) * 16 + r] = acc0[j]; red[w * 512 + (16 + 4 * q + j) * 16 + r] = acc1[j]; }
    __syncthreads();
    { float s = 0.f;
#pragma unroll
      for (int ww = 0; ww < 8; ++ww) s += red[ww * 512 + tid];
      out[tid] = s; }
    __syncthreads();
}

struct EpiZ {
    static constexpr bool PERM = true, AFTER_DRAIN = false;
    bf16 *QA, *KA, *VA, *ZR; float *krows, *vrows, *kpart; const float* rope;
    __device__ __forceinline__ void operator()(const pg8::f32x4 (&acc)[2][2][4][2], const pg8::Unit& u, int wr, int wc, int fr, int fq) const {
        using pg8::f32x4; using pg8::u32x4; using pg8::cvt_pk_bf16;
        const int pn = u.pn, row0 = u.pm * 256 + wr * 64 + fr, cin = wc * 32 + 8 * fq;
        if (pn >= 6) {
            bf16* base = ZR + (pn - 6) * 256 + cin;
#pragma unroll
            for (int ai = 0; ai < 2; ++ai)
#pragma unroll
                for (int m = 0; m < 4; ++m) { bf16* rowp = base + (size_t)(row0 + ai * 128 + m * 16) * 2048;
#pragma unroll
                    for (int bj = 0; bj < 2; ++bj) { const f32x4 v0 = acc[ai][bj][m][0], v1 = acc[ai][bj][m][1]; u32x4 w; w.x = cvt_pk_bf16(v0[0], v0[1]); w.y = cvt_pk_bf16(v0[2], v0[3]); w.z = cvt_pk_bf16(v1[0], v1[1]); w.w = cvt_pk_bf16(v1[2], v1[3]);
                        *(u32x4*)(rowp + bj * 128) = w; } }
        } else if (pn >= 4) {
            bf16* base = VA + (pn - 4) * 256 + cin; float* fb = vrows + (pn - 4) * 256 + cin;
#pragma unroll
            for (int ai = 0; ai < 2; ++ai)
#pragma unroll
                for (int m = 0; m < 4; ++m) { const size_t ro = (size_t)(row0 + ai * 128 + m * 16) * 512;
#pragma unroll
                    for (int bj = 0; bj < 2; ++bj) { const f32x4 v0 = acc[ai][bj][m][0], v1 = acc[ai][bj][m][1]; u32x4 w; w.x = cvt_pk_bf16(v0[0], v0[1]); w.y = cvt_pk_bf16(v0[2], v0[3]); w.z = cvt_pk_bf16(v1[0], v1[1]); w.w = cvt_pk_bf16(v1[2], v1[3]);
                        *(u32x4*)(base + ro + bj * 128) = w; *(f32x4*)(fb + ro + bj * 128) = v0; *(f32x4*)(fb + ro + bj * 128 + 4) = v1; } }
        } else {
            const bool isk = pn >= 2; const int pc = (pn & 1) * 256 + cin;
            bf16* base = (isk ? KA : QA) + pc; float* fb = krows + pc;
            const bool rot = (wc & 1) == 0;
            const float sg = (fq == 0) ? -1.f : 1.f; const bool mine = rot && fq < 2; const float osc = isk ? 1.f : QSCALE;
            f32x4 cs[2][2];
#pragma unroll
            for (int bj = 0; bj < 2; ++bj) { cs[bj][0] = (f32x4){0.f, 0.f, 0.f, 0.f}; cs[bj][1] = cs[bj][0]; }
#pragma unroll
            for (int ai = 0; ai < 2; ++ai)
#pragma unroll
                for (int m = 0; m < 4; ++m) { const int row = row0 + ai * 128 + m * 16; const size_t ro = (size_t)row * 512;
                    f32x4 c0 = {1.f, 1.f, 1.f, 1.f}, c1 = c0, s0 = {0.f, 0.f, 0.f, 0.f}, s1 = s0;
                    if (rot) { const float* rp = rope + (size_t)(row & (SEQ - 1)) * 16; c0 = *(const f32x4*)rp; c1 = *(const f32x4*)(rp + 4); s0 = *(const f32x4*)(rp + 8); s1 = *(const f32x4*)(rp + 12); }
#pragma unroll
                    for (int bj = 0; bj < 2; ++bj) { f32x4 v0 = acc[ai][bj][m][0], v1 = acc[ai][bj][m][1];
                        if (rot) { f32x4 p0, p1;
#pragma unroll
                            for (int j = 0; j < 4; ++j) { p0[j] = __shfl_xor(v0[j], 16); p1[j] = __shfl_xor(v1[j], 16); }
                            if (mine) { v0 = v0 * c0 + p0 * s0 * sg; v1 = v1 * c1 + p1 * s1 * sg; } }
                        if (isk) { *(f32x4*)(fb + ro + bj * 128) = v0; *(f32x4*)(fb + ro + bj * 128 + 4) = v1; cs[bj][0] += v0; cs[bj][1] += v1; }
                        v0 = v0 * osc; v1 = v1 * osc;
                        u32x4 w; w.x = cvt_pk_bf16(v0[0], v0[1]); w.y = cvt_pk_bf16(v0[2], v0[3]); w.z = cvt_pk_bf16(v1[0], v1[1]); w.w = cvt_pk_bf16(v1[2], v1[3]);
                        *(u32x4*)(base + ro + bj * 128) = w; } }
            if (isk) {
#pragma unroll
                for (int bj = 0; bj < 2; ++bj)
#pragma unroll
                    for (int n = 0; n < 2; ++n)
#pragma unroll
                        for (int j = 0; j < 4; ++j) { float s = cs[bj][n][j]; s += __shfl_xor(s, 1); s += __shfl_xor(s, 2); s += __shfl_xor(s, 4); s += __shfl_xor(s, 8); cs[bj][n][j] = s; }
                if (fr == 0) { float* kp = kpart + (size_t)(u.pm * 2 + wr) * 512 + pc;
#pragma unroll
                    for (int bj = 0; bj < 2; ++bj) { *(f32x4*)(kp + bj * 128) = cs[bj][0]; *(f32x4*)(kp + bj * 128 + 4) = cs[bj][1]; } }
            }
        }
    }
};

__device__ __forceinline__ void gate_unit(Frame& F, int u) {
    const int b = u >> 7, j = (u >> 2) & 31, qq = u & 3, h = F.wave, t = j * BLK + qq * 64 + F.lane;
    if (j == 0) return;
    LAS float* km = (LAS float*)(F.lds + RING_OFF);
    const float* kpart = (const float*)(F.ws + WS_KPART);
    for (int idx = F.tid; idx < j * 512; idx += NWAVES * 64) { const int n = idx >> 9, c = idx & 511; const float* p = kpart + (size_t)((b * NBLK + n) * 2) * 512 + c; km[idx] = p[0] + p[512]; }
    __syncthreads();
    const bf16* qrow = (const bf16*)(F.ws + WS_QA) + (size_t)(b * SEQ + t) * DATT + h * HD;
    float q[64];
#pragma unroll
    for (int c = 0; c < 8; ++c) { const v4u w = *(const GAS v4u*)(qrow + 8 * c); q[8 * c] = bflo(w.x); q[8 * c + 1] = bfhi(w.x); q[8 * c + 2] = bflo(w.y); q[8 * c + 3] = bfhi(w.y); q[8 * c + 4] = bflo(w.z); q[8 * c + 5] = bfhi(w.z); q[8 * c + 6] = bflo(w.w); q[8 * c + 7] = bfhi(w.w); }
    float v0 = -INFINITY, v1 = -INFINITY, v2 = -INFINITY; int i0 = -1, i1 = -1, i2 = -1;
    for (int n = 0; n < j; ++n) {
        const LAS f32x4* kp = (const LAS f32x4*)(km + n * 512 + h * HD);
        float d0 = 0.f, d1 = 0.f, d2 = 0.f, d3 = 0.f;
#pragma unroll
        for (int c = 0; c < 16; ++c) { const f32x4 kv = kp[c]; d0 += q[4 * c] * kv.x; d1 += q[4 * c + 1] * kv.y; d2 += q[4 * c + 2] * kv.z; d3 += q[4 * c + 3] * kv.w; }
        const float g = (d0 + d1) + (d2 + d3);
        if (g > v0) { v2 = v1; i2 = i1; v1 = v0; i1 = i0; v0 = g; i0 = n; }
        else if (g > v1) { v2 = v1; i2 = i1; v1 = g; i1 = n; }
        else if (g > v2) { v2 = g; i2 = n; }
    }
    unsigned* LIST = (unsigned*)(F.ws + WS_LIST);
    const unsigned long long ltmask = (1ull << F.lane) - 1ull;
    const int lbase = (b * NH + h) * NBLK;
    int mycnt = 0;
    for (int n = 0; n < j; ++n) { const bool sel = (i0 == n) || (i1 == n) || (i2 == n); const int c = __popcll(__ballot(sel)); if (F.lane == n) mycnt = c; }
    unsigned myoff = 0u;
    if (mycnt > 0) myoff = __hip_atomic_fetch_add(F.ctl + CW_TOT + lbase + F.lane, (unsigned)mycnt, __ATOMIC_RELAXED, __HIP_MEMORY_SCOPE_AGENT);
    for (int n = 0; n < j; ++n) {
        const bool sel = (i0 == n) || (i1 == n) || (i2 == n);
        const unsigned long long mask = __ballot(sel);
        const unsigned off = (unsigned)__shfl((int)myoff, n);
        if (sel) { const int slot = (i0 == n) ? 0 : (i1 == n) ? 1 : 2; LIST[(size_t)(lbase + n) * 8192 + off + __popcll(mask & ltmask)] = (unsigned)t | ((unsigned)slot << 16); }
    }
}

typedef short v4i16_t __attribute__((ext_vector_type(4)));
__device__ __forceinline__ int img_off(int row, int ch) { const int g = ((row >> 1) & 1) | (((row >> 3) & 1) << 1); return row * 128 + 16 * (ch ^ (g << 1)); }
__device__ __forceinline__ s16x4 tr_read(LAS unsigned char* p) { return __builtin_bit_cast(s16x4, __builtin_amdgcn_ds_read_tr16_b64_v4i16((LAS v4i16_t*)p)); }
__device__ __forceinline__ bf16x8 tr_frag(LAS unsigned char* img, int R0, int tile, int lane) {
    const int q = lane >> 4, i16 = lane & 15, qp = i16 >> 2, p = i16 & 3;
    const int r0 = R0 + 8 * q + qp, ch = 2 * tile + (p >> 1), bo = 8 * (p & 1);
    const s16x4 lo = tr_read(img + img_off(r0, ch) + bo), hi = tr_read(img + img_off(r0 + 4, ch) + bo);
    return __builtin_shufflevector(lo, hi, 0, 1, 2, 3, 4, 5, 6, 7);
}
__device__ __forceinline__ bf16x8 row_frag(LAS unsigned char* img, int ks, int tile, int lane) {
    const int q = lane >> 4, r = 16 * tile + (lane & 15);
    return *(const LAS bf16x8*)(img + img_off(r, 4 * ks + q));
}
__device__ __forceinline__ float sigmoidf_(float x) { return 1.f / (1.f + __expf(-x)); }

__device__ __forceinline__ void hgrn_h1(Frame& F, int id) {
    const int bh = id >> 7, c = id & 127, b = bh >> 3, h = bh & 7, lane = F.lane;
    LAS unsigned char* KL = F.lds + RING_OFF + F.wave * 16384; LAS unsigned char* VI = KL + 8192;
    const bf16* zr = (const bf16*)(F.ws + WS_ZR) + (size_t)(b * SEQ + c * CH) * 2048;
    const float lb = ((const float*)(F.ws + WS_SMALL + SM_LB))[h * 64 + lane];
    const bf16* fp = zr + 512 + h * 64 + lane;
    float bl = 0.f;
#pragma unroll 8
    for (int t = 0; t < CH; ++t) { const float f = lb + (1.f - lb) * sigmoidf_(bf2f(fp[(size_t)t * 2048])); bl += __log2f(f); }
    float bc = 0.f;
#pragma unroll 8
    for (int t = 0; t < CH; ++t) { const float f = lb + (1.f - lb) * sigmoidf_(bf2f(fp[(size_t)t * 2048])); bc += __log2f(f);
        const float kl = (1.f - f) * exp2f(bl - bc);
        *(LAS unsigned short*)(KL + img_off(t, lane >> 3) + 2 * (lane & 7)) = (unsigned short)f2bf(kl); }
    const bf16* vp = zr + 1024 + h * 64;
#pragma unroll
    for (int i = 0; i < 8; ++i) { const int idc = lane + 64 * i, row = idc >> 3, ch = idc & 7; *(LAS v4u*)(VI + img_off(row, ch)) = *(const GAS v4u*)(vp + (size_t)row * 2048 + 8 * ch); }
    LDS_WAIT(); asm volatile("" ::: "memory");
    float* UT = (float*)(F.ws + WS_UT) + (size_t)(bh * NCH + c) * 4096;
    ((float*)(F.ws + WS_DC))[(size_t)(bh * NCH + c) * 64 + lane] = exp2f(bl);
    const int q = lane >> 4, r = lane & 15;
#pragma unroll
    for (int vt = 0; vt < 4; ++vt) {
        const bf16x8 a0 = tr_frag(VI, 0, vt, lane), a1 = tr_frag(VI, 32, vt, lane);
#pragma unroll
        for (int kt = 0; kt < 4; ++kt) {
            const bf16x8 b0 = tr_frag(KL, 0, kt, lane), b1 = tr_frag(KL, 32, kt, lane);
            pg8::f32x4 acc = {0.f, 0.f, 0.f, 0.f};
            acc = MFMA16(a0, b0, acc); acc = MFMA16(a1, b1, acc);
#pragma unroll
            for (int jj = 0; jj < 4; ++jj) UT[(16 * vt + 4 * q + jj) * 64 + 16 * kt + r] = acc[jj];
        }
    }
    LDS_WAIT(); asm volatile("" ::: "memory");
}

__device__ __forceinline__ void sample_attn_unit(Frame& F, int u) {
    const int b = u >> 3, h = u & 7, tid = F.tid, lane = F.lane, w = F.wave;
    LAS float* sh = (LAS float*)(F.lds + RING_OFF);
    LAS float* qs = sh;
    LAS float* gate = sh + 64;
    LAS int* selp = (LAS int*)(sh + 96);
    LAS float* pbuf = sh + 128;
    LAS float* wred = sh + 1024;
    const float* zs = (const float*)(F.ws + WS_SMALL + SM_ZS) + (size_t)b * DIN;
    const float* rp = (const float*)(F.ws + WS_ROPE) + (size_t)PAST * 16;
    if (tid < 128) {
        const int isk = tid >> 6, d = tid & 63; const float* src = zs + isk * 512 + h * 64;
        float v = src[d];
        if (d < 16) { const int i = d & 7; const float c = rp[i], s = rp[8 + i]; v = (d < 8) ? v * c - src[d + 8] * s : v * c + src[d - 8] * s; }
        if (isk) F.out[O_KS + (size_t)b * DATT + h * 64 + d] = v; else qs[d] = v * QSCALE;
        if (isk) sh[1600 + d] = v;
    } else if (tid < 192) { const int d = tid - 128; const float v = zs[1024 + h * 64 + d]; F.out[O_VS + (size_t)b * DATT + h * 64 + d] = v; sh[1664 + d] = v; }
    __syncthreads();
    if (tid < 256) { const int n = tid >> 3, part = tid & 7; const float* ks = (const float*)(F.ws + WS_KSUMS) + (size_t)(b * NPAGES + 2 * n) * 512 + h * 64 + part * 8; float s = 0.f;
#pragma unroll
        for (int d = 0; d < 8; ++d) s += qs[part * 8 + d] * (ks[d] + ks[512 + d]);
        s += __shfl_xor(s, 1); s += __shfl_xor(s, 2); s += __shfl_xor(s, 4);
        if (part == 0) gate[n] = s; }
    __syncthreads();
    if (tid == 0) { float v0 = -INFINITY, v1 = -INFINITY, v2 = -INFINITY; int i0 = 0, i1 = 0, i2 = 0;
        for (int n = 0; n < 32; ++n) { const float g = gate[n];
            if (g > v0) { v2 = v1; i2 = i1; v1 = v0; i1 = i0; v0 = g; i0 = n; } else if (g > v1) { v2 = v1; i2 = i1; v1 = g; i1 = n; } else if (g > v2) { v2 = g; i2 = n; } }
        selp[0] = i0; selp[1] = i1; selp[2] = i2;
        selp[4] = F.pt[b * NPAGES + 2 * i0]; selp[5] = F.pt[b * NPAGES + 2 * i0 + 1]; selp[6] = F.pt[b * NPAGES + 2 * i1]; selp[7] = F.pt[b * NPAGES + 2 * i1 + 1]; selp[8] = F.pt[b * NPAGES + 2 * i2]; selp[9] = F.pt[b * NPAGES + 2 * i2 + 1]; }
    __syncthreads();
    { const int sub = lane & 3, kq = lane >> 2;
      f32x4 qv[4];
#pragma unroll
      for (int i = 0; i < 4; ++i) qv[i] = *(const LAS f32x4*)(qs + sub * 16 + 4 * i);
#pragma unroll
      for (int pass = 0; pass < 6; ++pass) { const int key = 96 * w + 16 * pass + kq, kin = key & 255;
          const int page = selp[4 + (key >> 7)];
          const GAS f32x4* kp = (const GAS f32x4*)(F.ck + ((size_t)page * PAGE + (kin & 127)) * DATT + h * 64 + sub * 16);
          float s = 0.f;
#pragma unroll
          for (int i = 0; i < 4; ++i) { const f32x4 kv = kp[i]; s += qv[i].x * kv.x + qv[i].y * kv.y + qv[i].z * kv.z + qv[i].w * kv.w; }
          s += __shfl_xor(s, 1); s += __shfl_xor(s, 2);
          if (sub == 0) pbuf[key] = s; } }
    __syncthreads();
    float sself = 0.f;
#pragma unroll 8
    for (int d = 0; d < 64; ++d) sself += qs[d] * sh[1600 + d];
    float mx = sself;
    for (int i = lane; i < 768; i += 64) mx = fmaxf(mx, pbuf[i]);
#pragma unroll
    for (int o = 1; o < 64; o <<= 1) mx = fmaxf(mx, __shfl_xor(mx, o));
    __syncthreads();
    for (int i = tid; i < 768; i += NWAVES * 64) pbuf[i] = exp2f(pbuf[i] - mx);
    __syncthreads();
    float lsum = 0.f;
    for (int i = lane; i < 768; i += 64) lsum += pbuf[i];
    lsum = wave_sum(lsum);
    const float pself = exp2f(sself - mx); lsum += pself;
    { const int kq = lane >> 4, dq = lane & 15;
      f32x4 o4 = {0.f, 0.f, 0.f, 0.f};
#pragma unroll
      for (int kk = 0; kk < 24; ++kk) { const int key = 96 * w + 4 * kk + kq, kin = key & 255;
          const int page = selp[4 + (key >> 7)];
          const f32x4 vv = *(const GAS f32x4*)(F.cv + ((size_t)page * PAGE + (kin & 127)) * DATT + h * 64 + 4 * dq);
          o4 += vv * pbuf[key]; }
#pragma unroll
      for (int c = 0; c < 4; ++c) { float x = o4[c]; x += __shfl_xor(x, 16); x += __shfl_xor(x, 32); o4[c] = x; }
      if (kq == 0) *(LAS f32x4*)(wred + w * 64 + 4 * dq) = o4; }
    __syncthreads();
    if (tid < 64) { float s = pself * sh[1664 + tid];
#pragma unroll
        for (int ww = 0; ww < 8; ++ww) s += wred[ww * 64 + tid];
        ((bf16*)(F.ws + WS_SMALL + SM_MIXS))[(size_t)b * DM + h * 64 + tid] = (bf16)f2bf(s / lsum); }
    __syncthreads();
}

__device__ __forceinline__ void sample_hgrn(Frame& F, int id) {
    const int b = id >> 3, h = id & 7, lane = F.lane;
    const float* zs = (const float*)(F.ws + WS_SMALL + SM_ZS) + (size_t)b * DIN;
    const float* LB = (const float*)(F.ws + WS_SMALL + SM_LB) + h * 64;
    const float* S0 = F.st0 + (size_t)(b * NH + h) * 4096; float* S1 = F.out + O_SS + (size_t)(b * NH + h) * 4096;
    const float iv = zs[2560 + h * 64 + lane];
    float o = 0.f;
#pragma unroll 8
    for (int k = 0; k < 64; ++k) { const float lb = LB[k], f = lb + (1.f - lb) * sigmoidf_(zs[2048 + h * 64 + k]); const float s = f * S0[k * 64 + lane] + (1.f - f) * iv; S1[k * 64 + lane] = s; o += s * zs[1536 + h * 64 + k]; }
    const float ms = wave_sum(o * o) * (1.f / 64.f); const float g = zs[3072 + h * 64 + lane];
    const float y = o * (1.f / sqrtf(ms + EPS)) * F.hg[lane] * (g * sigmoidf_(g));
    ((bf16*)(F.ws + WS_SMALL + SM_MIXS))[(size_t)b * DM + 512 + h * 64 + lane] = (bf16)f2bf(y);
}

constexpr int KSTR = 144, VSTR = 192;
constexpr int ATT_K = 0, ATT_V = 256 * KSTR, ATT_TAB = ATT_V + 256 * VSTR, ATT_END = ATT_TAB + 4096;
static_assert(ATT_END <= RING_BYTES, "attention LDS");
constexpr int TPU = 16;
typedef float f32x2_t __attribute__((ext_vector_type(2))); typedef __bf16 bf16x2_t __attribute__((ext_vector_type(2)));
__device__ __forceinline__ unsigned pkbf(float lo, float hi) { const f32x2_t v = {lo, hi}; const bf16x2_t b = __builtin_convertvector(v, bf16x2_t); return __builtin_bit_cast(unsigned, b); }

__device__ __forceinline__ int att_build_table(Frame& F) {
    LAS int* tab = (LAS int*)(F.lds + RING_OFF + ATT_TAB);
    LAS int* wsum = tab + 520;
    const int idx = F.tid, n = idx >> 4, bh = idx & 15;
    const int cnt = (int)__hip_atomic_load(F.ctl + CW_TOT + bh * NBLK + n, __ATOMIC_RELAXED, __HIP_MEMORY_SCOPE_AGENT);
    const int ntile = 8 + ((cnt + 31) >> 5), nu = (ntile + TPU - 1) / TPU;
    int inc = nu;
#pragma unroll
    for (int o = 1; o < 64; o <<= 1) { const int x = __shfl_up(inc, o); if (F.lane >= o) inc += x; }
    if (F.lane == 63) wsum[F.wave] = inc;
    __syncthreads();
    int base = 0;
    for (int w = 0; w < F.wave; ++w) base += wsum[w];
    tab[idx + 1] = base + inc; if (idx == 0) tab[0] = 0;
    __syncthreads();
    return tab[512];
}

__device__ __forceinline__ void attn_unit(Frame& F, int u) {
    LAS unsigned char* lds = F.lds + RING_OFF;
    LAS int* tab = (LAS int*)(lds + ATT_TAB);
    int lo = 0, hi = 512;
    while (hi - lo > 1) { const int mid = (lo + hi) >> 1; if (tab[mid] <= u) lo = mid; else hi = mid; }
    const int idx = lo, n = idx >> 4, bh = idx & 15, b = bh >> 3, head = bh & 7, li = bh * NBLK + n;
    const int cnt = (int)__hip_atomic_load(F.ctl + CW_TOT + li, __ATOMIC_RELAXED, __HIP_MEMORY_SCOPE_AGENT);
    const int ntile = 8 + ((cnt + 31) >> 5), tile0 = (u - tab[idx]) * TPU, tile1 = min(tile0 + TPU, ntile);
    const int lane = F.lane, r = lane & 31, hh = lane >> 5;
    { const bf16* kb = (const bf16*)(F.ws + WS_KA) + (size_t)(b * SEQ + n * BLK) * DATT + head * HD; const bf16* vb = (const bf16*)(F.ws + WS_VA) + (size_t)(b * SEQ + n * BLK) * DATT + head * HD;
#pragma unroll
      for (int i = 0; i < 4; ++i) { const int id = F.tid + 512 * i, row = id >> 3, ch = id & 7;
          const v4u kv = *(const GAS v4u*)(kb + (size_t)row * DATT + 8 * ch), vv = *(const GAS v4u*)(vb + (size_t)row * DATT + 8 * ch);
          *(LAS v4u*)(lds + ATT_K + row * KSTR + 16 * ch) = kv; *(LAS v4u*)(lds + ATT_V + row * VSTR + 16 * ch) = vv; } }
    __syncthreads();
    const unsigned* LIST = (const unsigned*)(F.ws + WS_LIST) + (size_t)li * 8192;
    const bf16* QA = (const bf16*)(F.ws + WS_QA);
    for (int ti = tile0 + F.wave; ti < tile1; ti += NWAVES) {
        int t, slot; bool valid = true;
        const bool diag = ti < 8;
        if (diag) { t = n * BLK + 32 * ti + r; slot = 3; }
        else { const int e = 32 * (ti - 8) + r; valid = e < cnt; const unsigned ent = LIST[valid ? e : (cnt - 1)]; t = (int)(ent & 0xffffu); slot = (int)(ent >> 16); }
        const bf16* qp = QA + (size_t)(b * SEQ + t) * DATT + head * HD + 8 * hh;
        bf16x8 qf[4];
#pragma unroll
        for (int ks = 0; ks < 4; ++ks) qf[ks] = *(const GAS bf16x8*)(qp + 16 * ks);
        f32x16 s[8];
        { const LAS unsigned char* kr = lds + ATT_K + r * KSTR + 16 * hh;
          bf16x8 kf[4], kn[4];
#pragma unroll
          for (int ks = 0; ks < 4; ++ks) kf[ks] = *(const LAS bf16x8*)(kr + 32 * ks);
#pragma unroll
          for (int kg = 0; kg < 8; ++kg) {
              if (kg < 7) {
#pragma unroll
                  for (int ks = 0; ks < 4; ++ks) kn[ks] = *(const LAS bf16x8*)(kr + (32 * (kg + 1)) * KSTR + 32 * ks); }
              f32x16 a = {0.f, 0.f, 0.f, 0.f, 0.f, 0.f, 0.f, 0.f, 0.f, 0.f, 0.f, 0.f, 0.f, 0.f, 0.f, 0.f};
#pragma unroll
              for (int ks = 0; ks < 4; ++ks) a = MFMA32(kf[ks], qf[ks], a);
              s[kg] = a;
#pragma unroll
              for (int ks = 0; ks < 4; ++ks) kf[ks] = kn[ks];
              __builtin_amdgcn_sched_barrier(0);
          } }
        if (diag) { const int qlh = 32 * ti + r - 4 * hh;
#pragma unroll
            for (int kg = 0; kg < 8; ++kg)
#pragma unroll
                for (int i = 0; i < 16; ++i) { if (32 * kg + (i & 3) + 8 * (i >> 2) > qlh) s[kg][i] = -1e30f; } }
        float m = s[0][0];
#pragma unroll
        for (int kg = 0; kg < 8; ++kg)
#pragma unroll
            for (int i = 0; i < 16; ++i) m = fmaxf(m, s[kg][i]);
        m = fmaxf(m, __shfl_xor(m, 32));
        float l = 0.f;
#pragma unroll
        for (int kg = 0; kg < 8; ++kg)
#pragma unroll
            for (int i = 0; i < 16; ++i) { const float p = __builtin_amdgcn_exp2f(s[kg][i] - m); s[kg][i] = p; l += p; }
        l += __shfl_xor(l, 32);
        f32x16 o0 = {0.f, 0.f, 0.f, 0.f, 0.f, 0.f, 0.f, 0.f, 0.f, 0.f, 0.f, 0.f, 0.f, 0.f, 0.f, 0.f}, o1 = o0;
        const int g16 = lane >> 4, i16 = lane & 15, qp4 = i16 >> 2, p4 = i16 & 3;
        const LAS unsigned char* vbase = lds + ATT_V + (4 * (g16 >> 1) + qp4) * VSTR + (16 * (g16 & 1) + 4 * p4) * 2;
        { s16x4 va[4], vn[4];
          va[0] = tr_read((LAS unsigned char*)vbase); va[1] = tr_read((LAS unsigned char*)(vbase + 8 * VSTR)); va[2] = tr_read((LAS unsigned char*)(vbase + 64)); va[3] = tr_read((LAS unsigned char*)(vbase + 8 * VSTR + 64));
#pragma unroll
          for (int it = 0; it < 16; ++it) { const int kg = it >> 1, st = it & 1;
              if (it < 15) { const LAS unsigned char* vk = vbase + (16 * (it + 1)) * VSTR;
                  vn[0] = tr_read((LAS unsigned char*)vk); vn[1] = tr_read((LAS unsigned char*)(vk + 8 * VSTR)); vn[2] = tr_read((LAS unsigned char*)(vk + 64)); vn[3] = tr_read((LAS unsigned char*)(vk + 8 * VSTR + 64)); }
              pg8::u32x4 pw; pw.x = pkbf(s[kg][8 * st], s[kg][8 * st + 1]); pw.y = pkbf(s[kg][8 * st + 2], s[kg][8 * st + 3]); pw.z = pkbf(s[kg][8 * st + 4], s[kg][8 * st + 5]); pw.w = pkbf(s[kg][8 * st + 6], s[kg][8 * st + 7]);
              const bf16x8 pf = __builtin_bit_cast(bf16x8, pw);
              o0 = MFMA32(__builtin_shufflevector(va[0], va[1], 0, 1, 2, 3, 4, 5, 6, 7), pf, o0);
              o1 = MFMA32(__builtin_shufflevector(va[2], va[3], 0, 1, 2, 3, 4, 5, 6, 7), pf, o1);
#pragma unroll
              for (int x = 0; x < 4; ++x) va[x] = vn[x];
              __builtin_amdgcn_sched_barrier(0);
          } }
        if (valid) {
            const size_t qh = (size_t)(b * SEQ + t) * NH + head;
            bf16* op = (bf16*)(F.ws + WS_OPART) + (qh * 4 + slot) * 64 + 4 * hh;
#pragma unroll
            for (int g = 0; g < 4; ++g) { u32x2 w0, w1; w0.x = pkbf(o0[4 * g], o0[4 * g + 1]); w0.y = pkbf(o0[4 * g + 2], o0[4 * g + 3]); w1.x = pkbf(o1[4 * g], o1[4 * g + 1]); w1.y = pkbf(o1[4 * g + 2], o1[4 * g + 3]);
                *(GAS u32x2*)(op + 8 * g) = w0; *(GAS u32x2*)(op + 32 + 8 * g) = w1; }
            if (hh == 0) { float* ml = (float*)(F.ws + WS_ML) + (qh * 4 + slot) * 2; ml[0] = m; ml[1] = l; }
        }
    }
    __syncthreads();
}

__device__ __forceinline__ void scan_unit(Frame& F, int s) {
    const int e = s * 512 + F.tid, bh = e >> 12, v = (e >> 6) & 63, k = e & 63;
    const float* up = (const float*)(F.ws + WS_UT) + (size_t)bh * NCH * 4096 + v * 64 + k;
    const float* dp = (const float*)(F.ws + WS_DC) + (size_t)bh * NCH * 64 + k;
    bf16* sp = (bf16*)(F.ws + WS_ST) + (size_t)bh * NCH * 4096 + v * 64 + k;
    float S = 0.f;
    for (int c0 = 0; c0 < NCH; c0 += 32) {
        float uu[32], dd[32];
#pragma unroll
        for (int i = 0; i < 32; ++i) { uu[i] = up[(size_t)(c0 + i) * 4096]; dd[i] = dp[(c0 + i) * 64]; }
#pragma unroll
        for (int i = 0; i < 32; ++i) { sp[(size_t)(c0 + i) * 4096] = (bf16)f2bf(S); S = dd[i] * S + uu[i]; }
    }
    F.out[O_SP + (size_t)bh * 4096 + k * 64 + v] = S;
}

__device__ __forceinline__ void hgrn_h3(Frame& F, int id) {
    const int bh = id >> 7, c = id & 127, b = bh >> 3, h = bh & 7, lane = F.lane, q = lane >> 4, r = lane & 15;
    LAS unsigned char* QD = F.lds + RING_OFF + F.wave * 16384; LAS unsigned char* KD = QD + 8192;
    const size_t row0 = (size_t)(b * SEQ + c * CH);
    const bf16* zr = (const bf16*)(F.ws + WS_ZR) + row0 * 2048;
    const float lb = ((const float*)(F.ws + WS_SMALL + SM_LB))[h * 64 + lane];
    const bf16* fp = zr + 512 + h * 64 + lane; const bf16* qp = zr + h * 64 + lane;
    float bc = 0.f;
#pragma unroll 8
    for (int t = 0; t < CH; ++t) { const float f = lb + (1.f - lb) * sigmoidf_(bf2f(fp[(size_t)t * 2048])); bc += __log2f(f);
        const float qd = bf2f(qp[(size_t)t * 2048]) * exp2f(bc), kd = (1.f - f) * exp2f(-bc);
        const int o = img_off(t, lane >> 3) + 2 * (lane & 7);
        *(LAS unsigned short*)(QD + o) = (unsigned short)f2bf(qd); *(LAS unsigned short*)(KD + o) = (unsigned short)f2bf(kd); }
    LDS_WAIT(); asm volatile("" ::: "memory");
    unsigned Ap[4][4][2];
#pragma unroll
    for (int st = 0; st < 4; ++st) {
        const bf16x8 k0 = row_frag(KD, 0, st, lane), k1 = row_frag(KD, 1, st, lane);
#pragma unroll
        for (int tt = 0; tt < 4; ++tt) { Ap[st][tt][0] = 0u; Ap[st][tt][1] = 0u;
            if (tt >= st) { pg8::f32x4 acc = {0.f, 0.f, 0.f, 0.f}; acc = MFMA16(k0, row_frag(QD, 0, tt, lane), acc); acc = MFMA16(k1, row_frag(QD, 1, tt, lane), acc);
                if (st == tt) {
#pragma unroll
                    for (int j = 0; j < 4; ++j) if (4 * q + j > r) acc[j] = 0.f; }
                Ap[st][tt][0] = pkbf(acc[0], acc[1]); Ap[st][tt][1] = pkbf(acc[2], acc[3]); } }
    }
    pg8::f32x4 o[4][4];
    const bf16* ST = (const bf16*)(F.ws + WS_ST) + (size_t)(bh * NCH + c) * 4096;
#pragma unroll
    for (int vt = 0; vt < 4; ++vt) {
        const bf16x8 s0 = *(const GAS bf16x8*)(ST + (size_t)(16 * vt + r) * 64 + 8 * q), s1 = *(const GAS bf16x8*)(ST + (size_t)(16 * vt + r) * 64 + 32 + 8 * q);
#pragma unroll
        for (int tt = 0; tt < 4; ++tt) { pg8::f32x4 acc = {0.f, 0.f, 0.f, 0.f}; acc = MFMA16(s0, row_frag(QD, 0, tt, lane), acc); acc = MFMA16(s1, row_frag(QD, 1, tt, lane), acc); o[vt][tt] = acc; }
    }
    LDS_WAIT(); asm volatile("" ::: "memory");
    const bf16* vp = zr + 1024 + h * 64;
#pragma unroll
    for (int i = 0; i < 8; ++i) { const int idc = lane + 64 * i, row = idc >> 3, ch = idc & 7; *(LAS v4u*)(QD + img_off(row, ch)) = *(const GAS v4u*)(vp + (size_t)row * 2048 + 8 * ch); }
    LDS_WAIT(); asm volatile("" ::: "memory");
    { const int i16 = lane & 15, qp4 = i16 >> 2, p4 = i16 & 3;
#pragma unroll
      for (int m = 0; m < 2; ++m)
#pragma unroll
        for (int vt = 0; vt < 4; ++vt) {
            const int r0 = 32 * m + 4 * q + qp4, ch = 2 * vt + (p4 >> 1), bo = 8 * (p4 & 1);
            const s16x4 lo = tr_read(QD + img_off(r0, ch) + bo), hi = tr_read(QD + img_off(r0 + 16, ch) + bo);
            const bf16x8 af = __builtin_shufflevector(lo, hi, 0, 1, 2, 3, 4, 5, 6, 7);
#pragma unroll
            for (int tt = 2 * m; tt < 4; ++tt) { pg8::u32x4 bw; bw.x = Ap[2 * m][tt][0]; bw.y = Ap[2 * m][tt][1]; bw.z = Ap[2 * m + 1][tt][0]; bw.w = Ap[2 * m + 1][tt][1];
                o[vt][tt] = MFMA16(af, __builtin_bit_cast(bf16x8, bw), o[vt][tt]); }
        } }
    bf16* mix = (bf16*)(F.ws + WS_XN) + row0 * DM + 512 + h * 64 + 4 * q; const bf16* gp = zr + 1536 + h * 64 + 4 * q;
    f32x4 gv[4];
#pragma unroll
    for (int vt = 0; vt < 4; ++vt) gv[vt] = *(const GAS f32x4*)(F.hg + 16 * vt + 4 * q);
#pragma unroll
    for (int tt = 0; tt < 4; ++tt) { float ss = 0.f;
#pragma unroll
        for (int vt = 0; vt < 4; ++vt) ss += (o[vt][tt][0] * o[vt][tt][0] + o[vt][tt][1] * o[vt][tt][1]) + (o[vt][tt][2] * o[vt][tt][2] + o[vt][tt][3] * o[vt][tt][3]);
        ss += __shfl_xor(ss, 16); ss += __shfl_xor(ss, 32);
        const float rstd = 1.f / sqrtf(ss * (1.f / 64.f) + EPS); const int t = 16 * tt + r;
#pragma unroll
        for (int vt = 0; vt < 4; ++vt) { const u32x2 gw = *(const GAS u32x2*)(gp + (size_t)t * 2048 + 16 * vt);
            const float g0 = bflo(gw.x), g1 = bfhi(gw.x), g2 = bflo(gw.y), g3 = bfhi(gw.y);
            u32x2 w; w.x = pk2(o[vt][tt][0] * rstd * gv[vt].x * (g0 * sigmoidf_(g0)), o[vt][tt][1] * rstd * gv[vt].y * (g1 * sigmoidf_(g1)));
            w.y = pk2(o[vt][tt][2] * rstd * gv[vt].z * (g2 * sigmoidf_(g2)), o[vt][tt][3] * rstd * gv[vt].w * (g3 * sigmoidf_(g3)));
            *(GAS u32x2*)(mix + (size_t)t * DM + 16 * vt) = w; } }
    LDS_WAIT(); asm volatile("" ::: "memory");
}

__device__ __forceinline__ void combine_items(Frame& F) {
    const bf16* OP = (const bf16*)(F.ws + WS_OPART); const float* ML = (const float*)(F.ws + WS_ML); bf16* mix = (bf16*)(F.ws + WS_XN);
    const int stride = F.G * NWAVES * 64;
    for (int it0 = blockIdx.x * (NWAVES * 64) + F.tid; it0 < MP * NH * 8; it0 += 4 * stride) {
        f32x4 ml0[4], ml1[4]; v4u x[4][4];
#pragma unroll
        for (int k = 0; k < 4; ++k) { const int it = it0 + k * stride, qh = it >> 3, g8 = it & 7;
            ml0[k] = *(const GAS f32x4*)(ML + (size_t)qh * 8); ml1[k] = *(const GAS f32x4*)(ML + (size_t)qh * 8 + 4);
            const bf16* op = OP + (size_t)qh * 256 + 8 * g8;
#pragma unroll
            for (int sl = 0; sl < 4; ++sl) x[k][sl] = *(const GAS v4u*)(op + sl * 64); }
#pragma unroll
        for (int k = 0; k < 4; ++k) { const int it = it0 + k * stride, qh = it >> 3, g8 = it & 7, row = qh >> 3, head = qh & 7, t = row & (SEQ - 1), nsel = min(3, t >> 8);
            const float m0 = nsel > 0 ? ml0[k].x : -1e30f, m1 = nsel > 1 ? ml0[k].z : -1e30f, m2 = nsel > 2 ? ml1[k].x : -1e30f, m3 = ml1[k].z;
            const float M = fmaxf(fmaxf(m0, m1), fmaxf(m2, m3));
            const float w0 = nsel > 0 ? exp2f(m0 - M) : 0.f, w1 = nsel > 1 ? exp2f(m1 - M) : 0.f, w2 = nsel > 2 ? exp2f(m2 - M) : 0.f, w3 = exp2f(m3 - M);
            const float L = (nsel > 0 ? w0 * ml0[k].y : 0.f) + (nsel > 1 ? w1 * ml0[k].w : 0.f) + (nsel > 2 ? w2 * ml1[k].y : 0.f) + w3 * ml1[k].w;
            const float inv = 1.f / L;
            float acc[8] = {0.f, 0.f, 0.f, 0.f, 0.f, 0.f, 0.f, 0.f};
#pragma unroll
            for (int sl = 0; sl < 4; ++sl) { const float w = sl == 0 ? w0 : sl == 1 ? w1 : sl == 2 ? w2 : w3;
                const v4u xx = x[k][sl];
                if (sl == 3 || sl < nsel) { acc[0] += w * bflo(xx.x); acc[1] += w * bfhi(xx.x); acc[2] += w * bflo(xx.y); acc[3] += w * bfhi(xx.y); acc[4] += w * bflo(xx.z); acc[5] += w * bfhi(xx.z); acc[6] += w * bflo(xx.w); acc[7] += w * bfhi(xx.w); } }
            v4u o; o.x = pk2(acc[0] * inv, acc[1] * inv); o.y = pk2(acc[2] * inv, acc[3] * inv); o.z = pk2(acc[4] * inv, acc[5] * inv); o.w = pk2(acc[6] * inv, acc[7] * inv);
            *(GAS v4u*)(mix + (size_t)row * DM + head * 64 + 8 * g8) = o; }
    }
}

struct EpiOut {
    static constexpr bool PERM = false, AFTER_DRAIN = true;
    const float* base; float* h1; bf16* hb; float* ssq;
    __device__ __forceinline__ void fused(pg8::f32x4 (&acc)[2][2][4][2], const pg8::Unit& u, int wr, int wc, int fr, int fq, PG8_LAS unsigned char* lds, int wid, int lane) const {
        using pg8::f32x4;
        PG8_LAS float* S = (PG8_LAS float*)lds;
        const int col0 = u.pn * 256 + wc * 32 + 4 * fq;
#pragma unroll
        for (int ai = 0; ai < 2; ++ai)
#pragma unroll
            for (int m = 0; m < 4; ++m) { const int r = ai * 128 + wr * 64 + m * 16 + fr; const size_t off = (size_t)(u.pm * 256 + r) * DM + col0; float ss = 0.f;
#pragma unroll
                for (int bj = 0; bj < 2; ++bj)
#pragma unroll
                    for (int n = 0; n < 2; ++n) { const f32x4 x = *(const f32x4*)(base + off + bj * 128 + n * 16); const f32x4 hv = x + acc[ai][bj][m][n];
                        *(f32x4*)(h1 + off + bj * 128 + n * 16) = hv; u32x2 w; w.x = pg8::cvt_pk_bf16(hv[0], hv[1]); w.y = pg8::cvt_pk_bf16(hv[2], hv[3]); *(u32x2*)(hb + off + bj * 128 + n * 16) = w;
                        ss += (hv[0] * hv[0] + hv[1] * hv[1]) + (hv[2] * hv[2] + hv[3] * hv[3]); }
                ss += __shfl_xor(ss, 16); ss += __shfl_xor(ss, 32);
                if (fq == 0) S[r * 4 + wc] = ss; }
        __syncthreads();
        const int tid = wid * 64 + lane;
        if (tid < 256) ssq[(size_t)(u.pm * 256 + tid) * 4 + u.pn] = (S[tid * 4] + S[tid * 4 + 1]) + (S[tid * 4 + 2] + S[tid * 4 + 3]);
        __syncthreads();
    }
};
struct EpiUp {
    static constexpr bool PERM = true, AFTER_DRAIN = false;
    bf16* O; const float* ssq;
    __device__ __forceinline__ void operator()(const pg8::f32x4 (&acc)[2][2][4][2], const pg8::Unit& u, int wr, int wc, int fr, int fq) const {
        using pg8::f32x4; using pg8::u32x4; using pg8::cvt_pk_bf16;
        const int row0 = u.pm * 256 + wr * 64 + fr, col0 = u.pn * 256 + wc * 32 + 8 * fq;
#pragma unroll
        for (int ai = 0; ai < 2; ++ai)
#pragma unroll
            for (int m = 0; m < 4; ++m) { const int row = row0 + ai * 128 + m * 16; const f32x4 s4 = *(const f32x4*)(ssq + (size_t)row * 4);
                const float rstd = 1.f / sqrtf(((s4.x + s4.y) + (s4.z + s4.w)) * (1.f / DM) + EPS); bf16* rowp = O + (size_t)row * DFF + col0;
#pragma unroll
                for (int bj = 0; bj < 2; ++bj) { f32x4 v0 = acc[ai][bj][m][0] * rstd, v1 = acc[ai][bj][m][1] * rstd;
#pragma unroll
                    for (int j = 0; j < 4; ++j) { const float a = fmaxf(v0[j], 0.f), c = fmaxf(v1[j], 0.f); v0[j] = a * a; v1[j] = c * c; }
                    u32x4 w; w.x = cvt_pk_bf16(v0[0], v0[1]); w.y = cvt_pk_bf16(v0[2], v0[3]); w.z = cvt_pk_bf16(v1[0], v1[1]); w.w = cvt_pk_bf16(v1[2], v1[3]);
                    *(u32x4*)(rowp + bj * 128) = w; } }
    }
};
struct EpiDown {
    static constexpr bool PERM = false, AFTER_DRAIN = true;
    const float* h1; float* out; float* ssq;
    __device__ __forceinline__ void fused(pg8::f32x4 (&acc)[2][2][4][2], const pg8::Unit& u, int wr, int wc, int fr, int fq, PG8_LAS unsigned char* lds, int wid, int lane) const {
        using pg8::f32x4;
        PG8_LAS float* S = (PG8_LAS float*)lds;
        const int col0 = u.pn * 256 + wc * 32 + 4 * fq;
#pragma unroll
        for (int ai = 0; ai < 2; ++ai)
#pragma unroll
            for (int m = 0; m < 4; ++m) { const int r = ai * 128 + wr * 64 + m * 16 + fr; const size_t off = (size_t)(u.pm * 256 + r) * DM + col0; float ss = 0.f;
#pragma unroll
                for (int bj = 0; bj < 2; ++bj)
#pragma unroll
                    for (int n = 0; n < 2; ++n) { const f32x4 x = *(const f32x4*)(h1 + off + bj * 128 + n * 16); const f32x4 hv = x + acc[ai][bj][m][n];
                        *(f32x4*)(out + off + bj * 128 + n * 16) = hv; ss += (hv[0] * hv[0] + hv[1] * hv[1]) + (hv[2] * hv[2] + hv[3] * hv[3]); }
                ss += __shfl_xor(ss, 16); ss += __shfl_xor(ss, 32);
                if (fq == 0) S[r * 4 + wc] = ss; }
        __syncthreads();
        const int tid = wid * 64 + lane;
        if (tid < 256) ssq[(size_t)(u.pm * 256 + tid) * 4 + u.pn] = (S[tid * 4] + S[tid * 4 + 1]) + (S[tid * 4 + 2] + S[tid * 4 + 3]);
        __syncthreads();
    }
};

__device__ __forceinline__ float row_rstd_1024(const float* p, int lane) { const GAS f32x4* xr = (const GAS f32x4*)p + lane; float s = 0.f;
#pragma unroll
    for (int j = 0; j < 4; ++j) { const f32x4 v = xr[64 * j]; s += (v.x * v.x + v.y * v.y) + (v.z * v.z + v.w * v.w); }
    return 1.f / sqrtf(wave_sum(s) * (1.f / DM) + EPS); }
__device__ __forceinline__ void sample_gemm1(Frame& F, int i) {
    LAS float* red = (LAS float*)(F.lds + RING_OFF); LAS float* tile = red + 4096;
    skinny32((const bf16*)(F.ws + WS_SMALL + SM_XS), DM, (const bf16*)(F.ws + WS_WIN), 16 * i, red, tile, F.tid);
    ((float*)(F.ws + WS_SMALL + SM_ZS))[(size_t)(F.tid >> 4) * DIN + 16 * i + (F.tid & 15)] = tile[F.tid];
    __syncthreads();
}
__device__ __forceinline__ void sample_wout(Frame& F, int i) {
    LAS float* red = (LAS float*)(F.lds + RING_OFF); LAS float* tile = red + 4096;
    skinny32((const bf16*)(F.ws + WS_SMALL + SM_MIXS), DM, (const bf16*)(F.ws + WS_WOUT), 16 * i, red, tile, F.tid);
    const int row = F.tid >> 4, col = 16 * i + (F.tid & 15); const float hv = F.xs[(size_t)row * DM + col] + tile[F.tid];
    ((float*)(F.ws + WS_SMALL + SM_H1S))[(size_t)row * DM + col] = hv; ((bf16*)(F.ws + WS_SMALL + SM_HBS))[(size_t)row * DM + col] = (bf16)f2bf(hv);
    __syncthreads();
}
__device__ __forceinline__ void sample_up(Frame& F, int i) {
    LAS float* red = (LAS float*)(F.lds + RING_OFF); LAS float* tile = red + 4096; LAS float* rs = red + 4096 + 512;
    const float* h1s = (const float*)(F.ws + WS_SMALL + SM_H1S);
    for (int rr = 0; rr < 4; ++rr) { const int row = F.wave * 4 + rr; const float x = row_rstd_1024(h1s + (size_t)row * DM, F.lane); if (F.lane == 0) rs[row] = x; }
    skinny32((const bf16*)(F.ws + WS_SMALL + SM_HBS), DM, (const bf16*)(F.ws + WS_WUP), 16 * i, red, tile, F.tid);
    const int row = F.tid >> 4, col = 16 * i + (F.tid & 15); const float a = fmaxf(tile[F.tid] * rs[row], 0.f);
    ((bf16*)(F.ws + WS_SMALL + SM_UPS))[(size_t)row * DFF + col] = (bf16)f2bf(a * a);
    __syncthreads();
}
__device__ __forceinline__ void sample_down(Frame& F, int i) {
    LAS float* red = (LAS float*)(F.lds + RING_OFF); LAS float* tile = red + 4096;
    skinny32((const bf16*)(F.ws + WS_SMALL + SM_UPS), DFF, (const bf16*)(F.ws + WS_WDOWN), 16 * i, red, tile, F.tid);
    const int row = F.tid >> 4, col = 16 * i + (F.tid & 15);
    ((float*)(F.ws + WS_SMALL + SM_H2S))[(size_t)row * DM + col] = ((const float*)(F.ws + WS_SMALL + SM_H1S))[(size_t)row * DM + col] + tile[F.tid];
    __syncthreads();
}
__device__ __forceinline__ void sample_final(Frame& F) {
    const float* h2s = (const float*)(F.ws + WS_SMALL + SM_H2S);
    for (int rr = 0; rr < 4; ++rr) { const int row = F.wave * 4 + rr; const float rstd = row_rstd_1024(h2s + (size_t)row * DM, F.lane);
#pragma unroll
        for (int j = 0; j < 4; ++j) { const int c = 4 * F.lane + 256 * j; const f32x4 v = *(const GAS f32x4*)(h2s + (size_t)row * DM + c), g = *(const GAS f32x4*)(F.gf + c); *(GAS f32x4*)(F.out + O_YS + (size_t)row * DM + c) = v * rstd * g; } }
}
__device__ __forceinline__ void final_norm(Frame& F) {
    const float* ssq = (const float*)(F.ws + WS_SSQ2); const int gw = blockIdx.x * NWAVES + F.wave, NGW = F.G * NWAVES;
    f32x4 g[4];
#pragma unroll
    for (int j = 0; j < 4; ++j) g[j] = *(const GAS f32x4*)(F.gf + 4 * F.lane + 256 * j);
    for (int m = gw; m < MP; m += NGW) { const f32x4 s4 = *(const GAS f32x4*)(ssq + (size_t)m * 4); const float rstd = 1.f / sqrtf(((s4.x + s4.y) + (s4.z + s4.w)) * (1.f / DM) + EPS);
        GAS f32x4* y = (GAS f32x4*)(F.out + O_YP + (size_t)m * DM) + F.lane;
#pragma unroll
        for (int j = 0; j < 4; ++j) y[64 * j] = y[64 * j] * rstd * g[j]; }
}

#ifndef MK_PER_PHASE
#define MK_PER_PHASE 0
#endif
constexpr int N_PHASES = 9;
struct Args { const void* in[15]; float* out; unsigned char* ws; int ph_lo, ph_hi; };
__global__ void __launch_bounds__(NWAVES * 64, 2) hymba_fwd(Args args) {
    extern __shared__ __attribute__((aligned(16))) unsigned char lds[];
    Frame F;
    F.lds = (LAS unsigned char*)lds;
    F.MISC = (volatile LAS unsigned*)(F.lds + MISC_OFF);
    F.tid = threadIdx.x; F.lane = F.tid & 63; F.wave = __builtin_amdgcn_readfirstlane(F.tid >> 6);
    F.G = gridDim.x;
    F.ws = args.ws; F.out = args.out; F.ctl = (gu32*)(args.ws + WS_CTL);
    F.xp = (const float*)args.in[0]; F.xs = (const float*)args.in[1]; F.ck = (const float*)args.in[2]; F.cv = (const float*)args.in[3]; F.st0 = (const float*)args.in[4]; F.pt = (const int*)args.in[5];
    F.g1 = (const float*)args.in[6]; F.win = (const float*)args.in[7]; F.lbl = (const float*)args.in[8]; F.hg = (const float*)args.in[9]; F.wout = (const float*)args.in[10]; F.g2 = (const float*)args.in[11];
    F.wup = (const float*)args.in[12]; F.wdown = (const float*)args.in[13]; F.gf = (const float*)args.in[14];
    for (int u = F.tid; u < (LDS_BYTES - LDSCTL_OFF) / 4; u += NWAVES * 64) ((LAS unsigned*)(F.lds + LDSCTL_OFF))[u] = 0u;
    __syncthreads();
    XcdBarrier bar; bar.bar = (unsigned*)(F.ctl + CW_BAR); bar.x = 0; bar.st = nullptr;
    if (!MK_PER_PHASE) bar = xcd_barrier_post((unsigned*)(F.ctl + CW_BAR), F.MISC + 8);
#define GRID_BAR() do { if (!MK_PER_PHASE) xcd_barrier(bar); } while (0)
    const int lo = args.ph_lo, hi = args.ph_hi; const int bx = blockIdx.x;
#ifndef ONLY_PHASE
#define ONLY_PHASE -1
#endif
#define IN(k) ((ONLY_PHASE < 0 || ONLY_PHASE == (k)) && lo <= (k) && (k) < hi)
#define BOTH(k) (IN(k) && IN((k) + 1))
    bf16* Win_t = (bf16*)(F.ws + WS_WIN); bf16* Wout_t = (bf16*)(F.ws + WS_WOUT); bf16* Wup_t = (bf16*)(F.ws + WS_WUP); bf16* Wdown_t = (bf16*)(F.ws + WS_WDOWN);
    bf16* XN = (bf16*)(F.ws + WS_XN); bf16* HB = (bf16*)(F.ws + WS_HB); bf16* UPB = (bf16*)(F.ws + WS_UP); float* H1 = (float*)(F.ws + WS_H1);

    if (IN(0)) { p0_prologue(F); if (BOTH(0)) GRID_BAR(); }
    if (IN(1)) {
        if (bx < DIN / 16) sample_gemm1(F, bx);
        pg8::Gemm g{XN, Win_t, MP, DIN, DM}; pg8::StaticOrder S; S.init(MP, DIN, F.G, bx);
        EpiZ E{(bf16*)(F.ws + WS_QA), (bf16*)(F.ws + WS_KA), (bf16*)(F.ws + WS_VA), (bf16*)(F.ws + WS_ZR), F.out + O_KP, F.out + O_VP, (float*)(F.ws + WS_KPART), (const float*)(F.ws + WS_ROPE)};
        pg8::gemm_phase<EpiZ, pg8::StaticOrder, true, true>(F.lds + RING_OFF, g, S, E);
        if (bx >= 128) for (int i = 0; i < KSUM_P1_PER_WG; ++i) ksum_item(F, KSUM_P0 + (bx - 128) * KSUM_P1_PER_WG + i);
        if (BOTH(1)) GRID_BAR();
    }
    if (IN(2)) {
        for (int u = bx; u < NB * NBLK * 4; u += F.G) { gate_unit(F, u); __syncthreads(); }
        for (int id = bx * NWAVES + F.wave; id < NB * NH * NCH; id += F.G * NWAVES) hgrn_h1(F, id);
        __syncthreads();
        for (int u = bx; u < DECB * NH; u += F.G) sample_attn_unit(F, u);
        for (int id = bx * NWAVES + F.wave; id < DECB * NH; id += F.G * NWAVES) sample_hgrn(F, id);
        if (BOTH(2)) GRID_BAR();
    }
    if (IN(3)) {
        if (bx < DM / 16) sample_wout(F, bx);
        if (bx >= 64 && bx < 64 + 128) scan_unit(F, bx - 64);
        const int NU = att_build_table(F);
        for (int u = bx; u < NU; u += F.G) attn_unit(F, u);
        if (BOTH(3)) GRID_BAR();
    }
    if (IN(4)) {
#ifndef P4_PARTS
#define P4_PARTS 7
#endif
        if (P4_PARTS & 1) for (int id = bx * NWAVES + F.wave; id < NB * NH * NCH; id += F.G * NWAVES) hgrn_h3(F, id);
        __syncthreads();
        if (P4_PARTS & 2) combine_items(F);
        if (P4_PARTS & 4) for (int u = bx; u < DFF / 16; u += F.G) sample_up(F, u);
        if (BOTH(4)) GRID_BAR();
    }
    if (IN(5)) {
        if (bx < DM / 16) sample_down(F, bx);
        pg8::Gemm g{XN, Wout_t, MP, DM, DM}; pg8::StaticOrder S; S.init(MP, DM, F.G, bx);
        EpiOut E{F.xp, H1, HB, (float*)(F.ws + WS_SSQ1)};
        pg8::gemm_phase<EpiOut, pg8::StaticOrder, false, true>(F.lds + RING_OFF, g, S, E);
        if (BOTH(5)) GRID_BAR();
    }
    if (IN(6)) {
        if (bx == 0) sample_final(F);
        pg8::Gemm g{HB, Wup_t, MP, DFF, DM}; pg8::StaticOrder S; S.init(MP, DFF, F.G, bx);
        EpiUp E{UPB, (const float*)(F.ws + WS_SSQ1)};
        pg8::gemm_phase<EpiUp, pg8::StaticOrder, true, true>(F.lds + RING_OFF, g, S, E);
        if (BOTH(6)) GRID_BAR();
    }
    if (IN(7)) {
        pg8::Gemm g{UPB, Wdown_t, MP, DM, DFF}; pg8::StaticOrder S; S.init(MP, DM, F.G, bx);
        EpiDown E{H1, F.out + O_YP, (float*)(F.ws + WS_SSQ2)};
        pg8::gemm_phase<EpiDown, pg8::StaticOrder, false, true>(F.lds + RING_OFF, g, S, E);
        if (BOTH(7)) GRID_BAR();
    }
    if (IN(8)) final_norm(F);
#undef IN
#undef BOTH
}

#ifdef PROBE_DUMP
__global__ void probe_dump(const unsigned short* src, float* dst, size_t n, int c0, int c1) {
    for (size_t i = (size_t)blockIdx.x * blockDim.x + threadIdx.x; i < n; i += (size_t)gridDim.x * blockDim.x) { const int c = (int)(i & 1023); dst[i] = (c >= c0 && c < c1) ? __builtin_bit_cast(float, (unsigned)src[i] << 16) : 0.f; }
}
#endif
extern "C" void kernel_launch(void* const* d_in, const int* in_sizes, int n_in, void* d_out, int out_size, void* d_ws, size_t ws_size, hipStream_t stream) {
    static int grid = 0;
    if (grid == 0) {
        if (n_in != 15 || (size_t)out_size != O_END || ws_size < WS_END) { fprintf(stderr, "kernel_launch: unexpected problem (n_in %d, out %d, ws %zu); nothing launched\n", n_in, out_size, ws_size); grid = -1; return; }
        int dev = 0, cus = 0;
        if (hipGetDevice(&dev) != hipSuccess || hipDeviceGetAttribute(&cus, hipDeviceAttributeMultiprocessorCount, dev) != hipSuccess) { grid = -1; return; }
        if (hipFuncSetAttribute((const void*)hymba_fwd, hipFuncAttributeMaxDynamicSharedMemorySize, LDS_BYTES) != hipSuccess) { fprintf(stderr, "kernel_launch: hipFuncSetAttribute failed\n"); grid = -1; return; }
        int per_cu = 0;
        if (hipOccupancyMaxActiveBlocksPerMultiprocessor(&per_cu, (const void*)hymba_fwd, NWAVES * 64, LDS_BYTES) != hipSuccess || per_cu < 1) fprintf(stderr, "kernel_launch: occupancy query reports %d\n", per_cu);
        (void)hipGetLastError();
        grid = cus;
        if (grid != 256) { fprintf(stderr, "kernel_launch: built for a 256-CU device, found %d CUs; nothing launched\n", cus); grid = -1; return; }
    }
    if (grid < 0) return;
    if (hipMemsetAsync((char*)d_ws + WS_CTL, 0, CTL_ZERO_BYTES, stream) != hipSuccess) return;
    Args a{};
    for (int i = 0; i < 15; ++i) a.in[i] = d_in[i];
    a.out = (float*)d_out; a.ws = (unsigned char*)d_ws;
#ifndef RUN_PHASES
#define RUN_PHASES N_PHASES
#endif
#if MK_PER_PHASE
    if (RUN_PHASES < N_PHASES) (void)hipMemsetAsync(d_out, 0, O_END * sizeof(float), stream);
#ifndef DUP_PHASE
#endif
#ifdef DUP_ALL
    for (int p = 0; p < N_PHASES; ++p) { a.ph_lo = p; a.ph_hi = p + 1; hipLaunchKernelGGL(hymba_fwd, dim3(grid), dim3(NWAVES * 64), LDS_BYTES, stream, a); }
    (void)hipMemsetAsync((char*)d_ws + WS_CTL + CW_TOT * 4, 0, 512 * 4, stream);
#endif
    for (int p = 0; p < RUN_PHASES; ++p) { a.ph_lo = p; a.ph_hi = p + 1;
        for (int rep = 0; rep < (p == DUP_PHASE ? 2 : 1); ++rep) {
            if (rep == 1 && p == 2) (void)hipMemsetAsync((char*)d_ws + WS_CTL + CW_TOT * 4, 0, 512 * 4, stream);
            hipLaunchKernelGGL(hymba_fwd, dim3(grid), dim3(NWAVES * 64), LDS_BYTES, stream, a); } }
#ifdef PROBE_DUMP
    hipLaunchKernelGGL(probe_dump, dim3(2048), dim3(256), 0, stream, (const unsigned short*)((unsigned char*)d_ws + PROBE_SRC), (float*)d_out + O_YP, (size_t)MP * DM, PROBE_C0, PROBE_C1);
#endif
#else
    a.ph_lo = 0; a.ph_hi = N_PHASES;
    hipLaunchKernelGGL(hymba_fwd, dim3(grid), dim3(NWAVES * 64), LDS_BYTES, stream, a);
#endif
    const hipError_t le = hipPeekAtLastError();
    if (le != hipSuccess) fprintf(stderr, "kernel_launch: launch failed: %s\n", hipGetErrorName(le));
}
```
